# Optimizing an MI355X kernel written in HIP

```python
import numpy as np
import jax, jax.numpy as jnp
from jax import lax

D_MODEL = 2048
BATCH = 8
SEQ = 2048
DEPTH = 1

EPS = 1e-6
NEG_INF = -1e30
FORCE = 1e9
ROPE_THETA = 500000.0
Q_BLOCK = 128

MLA_HEADS = 16
MLA_NOPE = 128
MLA_ROPE = 64
MLA_QK = MLA_NOPE + MLA_ROPE
MLA_V = 128
MLA_Q_RANK = 512
MLA_KV_RANK = 512

NSA_HEADS = 16
NSA_GROUPS = 4
NSA_HPG = NSA_HEADS // NSA_GROUPS
NSA_DK = 192
NSA_DV = 128
NSA_ROPE = NSA_DK // 4
CMP_LEN = 32
CMP_STRIDE = 16
CMP_HIDDEN_K = 4 * NSA_DK
CMP_HIDDEN_V = 4 * NSA_DV
SLC_LEN = 64
SLC_TOPK = 16
WINDOW = 512
SLC_Q_CHUNK = 32

N_BRANCHES = 2
D_FF = -(-8 * D_MODEL // (3 * 256)) * 256

IN_SIZES = (
    MLA_Q_RANK, MLA_KV_RANK, MLA_ROPE,
    NSA_HEADS * NSA_DK,
    NSA_GROUPS * NSA_DK, NSA_GROUPS * NSA_DV,
    NSA_GROUPS * NSA_DK, NSA_GROUPS * NSA_DV,
    NSA_GROUPS * NSA_DK, NSA_GROUPS * NSA_DV,
    NSA_HEADS * 3,
    N_BRANCHES * D_MODEL,
)
D_IN = sum(IN_SIZES)

kernel_name = "hybrid_mla_nsa_gated_swiglu"


def rmsnorm(x, g):
    xf = x.astype(jnp.float32)
    y = xf * lax.rsqrt(jnp.mean(xf * xf, axis=-1, keepdims=True) + EPS)
    return (y * g.astype(jnp.float32)).astype(x.dtype)


def rope_tables(pos, rot_dim):
    inv = ROPE_THETA ** (-jnp.arange(0, rot_dim, 2, dtype=jnp.float32) / rot_dim)
    ang = pos.astype(jnp.float32)[:, None] * inv[None, :]
    return jnp.cos(ang), jnp.sin(ang)


def apply_rope(x, cos, sin, start, rot_dim):
    half = rot_dim // 2
    xr = x[..., start:start + rot_dim].astype(jnp.float32)
    x1, x2 = xr[..., :half], xr[..., half:]
    rot = jnp.concatenate([x1 * cos - x2 * sin, x2 * cos + x1 * sin], axis=-1).astype(x.dtype)
    return jnp.concatenate([x[..., :start], rot, x[..., start + rot_dim:]], axis=-1)


def masked_softmax(s, mask):
    s = jnp.where(mask, s, NEG_INF)
    m = jnp.max(s, axis=-1, keepdims=True)
    p = jnp.where(mask, jnp.exp(s - m), 0.0)
    return p / jnp.maximum(jnp.sum(p, axis=-1, keepdims=True), 1e-30)


def dense_causal_attention(q, k, v, scale):
    T = q.shape[2]
    outs = []
    for c in range(T // Q_BLOCK):
        s0, e = c * Q_BLOCK, (c + 1) * Q_BLOCK
        s = jnp.einsum('bhqd,bhkd->bhqk', q[:, :, s0:e], k[:, :, :e]).astype(jnp.float32) * scale
        mask = jnp.arange(e)[None, :] <= jnp.arange(s0, e)[:, None]
        p = masked_softmax(s, mask)
        outs.append(jnp.einsum('bhqk,bhkd->bhqd', p.astype(v.dtype), v[:, :, :e]))
    return jnp.concatenate(outs, axis=2)


def sliding_window_attention(q, k, v, scale):
    B, G, R, T, _ = q.shape
    span = Q_BLOCK + WINDOW
    k_pad = jnp.pad(k, ((0, 0), (0, 0), (WINDOW, 0), (0, 0)))
    v_pad = jnp.pad(v, ((0, 0), (0, 0), (WINDOW, 0), (0, 0)))

    def block(c):
        s0 = c * Q_BLOCK
        qb = lax.dynamic_slice_in_dim(q, s0, Q_BLOCK, axis=3)
        kb = lax.dynamic_slice_in_dim(k_pad, s0, span, axis=2)
        vb = lax.dynamic_slice_in_dim(v_pad, s0, span, axis=2)
        t = s0 + jnp.arange(Q_BLOCK)
        pk = s0 - WINDOW + jnp.arange(span)
        d = t[:, None] - pk[None, :]
        mask = (pk[None, :] >= 0) & (d >= 0) & (d < WINDOW)
        s = jnp.einsum('bgrqd,bgkd->bgrqk', qb, kb).astype(jnp.float32) * scale
        p = masked_softmax(s, mask)
        return jnp.einsum('bgrqk,bgkd->bgrqd', p.astype(vb.dtype), vb)

    o = lax.map(block, jnp.arange(T // Q_BLOCK))
    o = jnp.moveaxis(o, 0, 3)
    return o.reshape(B, G, R, T, o.shape[-1])


def compress_blocks(x, pe, w1, b1, w2, b2):
    T = x.shape[2]
    ncmp = (T - CMP_LEN) // CMP_STRIDE + 1
    idx = np.arange(ncmp)[:, None] * CMP_STRIDE + np.arange(CMP_LEN)[None, :]
    blocks = x[:, :, idx] + pe
    flat = blocks.reshape(blocks.shape[:3] + (-1,))
    return jax.nn.gelu(flat @ w1 + b1) @ w2 + b2


def select_blocks(p_cmp, T):
    nb = T // SLC_LEN
    ncmp = p_cmp.shape[-1]
    cs = np.arange(ncmp)[:, None] * CMP_STRIDE
    ss = np.arange(nb)[None, :] * SLC_LEN
    overlap = np.clip(np.minimum(cs + CMP_LEN, ss + SLC_LEN) - np.maximum(cs, ss), 0, None) / CMP_LEN
    imp = jnp.einsum('bgrtc,cj->bgtj', p_cmp, jnp.asarray(overlap, jnp.float32))
    tb = jnp.arange(T)[:, None] // SLC_LEN
    jb = jnp.arange(nb)[None, :]
    forced = (jb == 0) | (jb == tb) | (jb == tb - 1)
    valid = jb <= tb
    score = jnp.where(forced, FORCE, jnp.where(valid, imp, -FORCE))
    _, idx = lax.top_k(score, min(SLC_TOPK, nb))
    return idx


def selected_block_attention(q, k, v, sel_idx, scale):
    B, G, R, T, _ = q.shape
    nb = T // SLC_LEN
    n = sel_idx.shape[-1]
    kb_all = k.reshape(B, G, nb, SLC_LEN, k.shape[-1])
    vb_all = v.reshape(B, G, nb, SLC_LEN, v.shape[-1])
    bi = jnp.arange(B)[:, None, None, None]
    gi = jnp.arange(G)[None, :, None, None]

    def chunk(c):
        s0 = c * SLC_Q_CHUNK
        qc = lax.dynamic_slice_in_dim(q, s0, SLC_Q_CHUNK, axis=3)
        idx = lax.dynamic_slice_in_dim(sel_idx, s0, SLC_Q_CHUNK, axis=2)
        kg = kb_all[bi, gi, idx]
        vg = vb_all[bi, gi, idx]
        s = jnp.einsum('bgrqd,bgqnld->bgrqnl', qc, kg).astype(jnp.float32) * scale
        t = s0 + jnp.arange(SLC_Q_CHUNK)
        pk = idx[..., None] * SLC_LEN + jnp.arange(SLC_LEN)
        mask = (pk <= t[None, None, :, None, None])[:, :, None].reshape(B, G, 1, SLC_Q_CHUNK, n * SLC_LEN)
        p = masked_softmax(s.reshape(B, G, R, SLC_Q_CHUNK, n * SLC_LEN), mask)
        p = p.reshape(B, G, R, SLC_Q_CHUNK, n, SLC_LEN)
        return jnp.einsum('bgrqnl,bgqnld->bgrqd', p.astype(vg.dtype), vg)

    o = lax.map(chunk, jnp.arange(T // SLC_Q_CHUNK))
    o = jnp.moveaxis(o, 0, 3)
    return o.reshape(B, G, R, T, o.shape[-1])


def hybrid_layer(x, attn_norm_g, w_in, mla_q_lat_g, mla_kv_lat_g, mla_w_uq, mla_w_uk, mla_w_uv,
                 mla_q_norm_g, mla_k_norm_g, nsa_q_norm_g, nsa_k_norm_g, cmp_pe_k, cmp_pe_v,
                 cmp_k_w1, cmp_k_b1, cmp_k_w2, cmp_k_b2, cmp_v_w1, cmp_v_b1, cmp_v_w2, cmp_v_b2,
                 w_proj_mla, w_proj_nsa, w_out, ffn_norm_g, w_ffn_gate, w_ffn_up, w_ffn_down):
    B, T, _ = x.shape
    pos = jnp.arange(T)
    xn = rmsnorm(x, attn_norm_g)
    proj = xn @ w_in
    offsets = [int(o) for o in np.cumsum(IN_SIZES)[:-1]]
    (cq, ckv, kr, q_nsa, kc, vc, ks, vs, kw, vw, g_nsa, g_merge) = jnp.split(proj, offsets, axis=-1)

    cq = rmsnorm(cq, mla_q_lat_g)
    q = (cq @ mla_w_uq).reshape(B, T, MLA_HEADS, MLA_QK).transpose(0, 2, 1, 3)
    ckv = rmsnorm(ckv, mla_kv_lat_g)
    k_nope = (ckv @ mla_w_uk).reshape(B, T, MLA_HEADS, MLA_NOPE).transpose(0, 2, 1, 3)
    v = (ckv @ mla_w_uv).reshape(B, T, MLA_HEADS, MLA_V).transpose(0, 2, 1, 3)
    k_rope = jnp.broadcast_to(kr[:, None], (B, MLA_HEADS, T, MLA_ROPE))
    k = jnp.concatenate([k_nope, k_rope], axis=-1)
    cos_m, sin_m = rope_tables(pos, MLA_ROPE)
    q = apply_rope(rmsnorm(q, mla_q_norm_g), cos_m, sin_m, MLA_NOPE, MLA_ROPE)
    k = apply_rope(rmsnorm(k, mla_k_norm_g), cos_m, sin_m, MLA_NOPE, MLA_ROPE)
    o_mla = dense_causal_attention(q, k, v, MLA_QK ** -0.5)
    y_mla = o_mla.transpose(0, 2, 1, 3).reshape(B, T, MLA_HEADS * MLA_V) @ w_proj_mla

    scale = NSA_DK ** -0.5
    cos_n, sin_n = rope_tables(pos, NSA_ROPE)
    qn = q_nsa.reshape(B, T, NSA_HEADS, NSA_DK).transpose(0, 2, 1, 3)
    qn = apply_rope(rmsnorm(qn, nsa_q_norm_g), cos_n, sin_n, 0, NSA_ROPE)
    qn = qn.reshape(B, NSA_GROUPS, NSA_HPG, T, NSA_DK)

    def kv_heads(t, d):
        return t.reshape(B, T, NSA_GROUPS, d).transpose(0, 2, 1, 3)

    k_c = compress_blocks(kv_heads(kc, NSA_DK), cmp_pe_k, cmp_k_w1, cmp_k_b1, cmp_k_w2, cmp_k_b2)
    v_c = compress_blocks(kv_heads(vc, NSA_DV), cmp_pe_v, cmp_v_w1, cmp_v_b1, cmp_v_w2, cmp_v_b2)
    ncmp = k_c.shape[2]
    cmp_end = jnp.arange(ncmp) * CMP_STRIDE + CMP_LEN - 1
    cos_c, sin_c = rope_tables(cmp_end, NSA_ROPE)
    k_c = apply_rope(rmsnorm(k_c, nsa_k_norm_g[0]), cos_c, sin_c, 0, NSA_ROPE)
    s_c = jnp.einsum('bgrtd,bgcd->bgrtc', qn, k_c).astype(jnp.float32) * scale
    p_c = masked_softmax(s_c, cmp_end[None, :] <= pos[:, None])
    o_c = jnp.einsum('bgrtc,bgcd->bgrtd', p_c.astype(v_c.dtype), v_c)

    sel_idx = select_blocks(p_c, T)
    k_s = apply_rope(rmsnorm(kv_heads(ks, NSA_DK), nsa_k_norm_g[1]), cos_n, sin_n, 0, NSA_ROPE)
    o_s = selected_block_attention(qn, k_s, kv_heads(vs, NSA_DV), sel_idx, scale)

    k_w = apply_rope(rmsnorm(kv_heads(kw, NSA_DK), nsa_k_norm_g[2]), cos_n, sin_n, 0, NSA_ROPE)
    o_w = sliding_window_attention(qn, k_w, kv_heads(vw, NSA_DV), scale)

    g = jax.nn.sigmoid(g_nsa.astype(jnp.float32)).astype(x.dtype)
    g = g.reshape(B, T, NSA_GROUPS, NSA_HPG, 3).transpose(0, 2, 3, 1, 4)
    o_nsa = g[..., 0:1] * o_c + g[..., 1:2] * o_s + g[..., 2:3] * o_w
    y_nsa = o_nsa.transpose(0, 3, 1, 2, 4).reshape(B, T, NSA_HEADS * NSA_DV) @ w_proj_nsa

    gm = jax.nn.sigmoid(g_merge.astype(jnp.float32)).astype(x.dtype).reshape(B, T, N_BRANCHES, D_MODEL)
    h = x + (gm[:, :, 0] * y_mla + gm[:, :, 1] * y_nsa) @ w_out

    hn = rmsnorm(h, ffn_norm_g)
    ff = (jax.nn.silu(hn @ w_ffn_gate) * (hn @ w_ffn_up)) @ w_ffn_down
    return h + ff


def setup_inputs(seed: int = 0) -> dict:
    key = jax.random.key(seed)
    keys = iter(jax.random.split(key, 32))

    def w(shape, fan_in):
        return jax.random.normal(next(keys), (DEPTH,) + shape, jnp.float32) * fan_in ** -0.5

    def gain(shape):
        return 1.0 + 0.01 * jax.random.normal(next(keys), (DEPTH,) + shape, jnp.float32)

    def small(shape, s):
        return s * jax.random.normal(next(keys), (DEPTH,) + shape, jnp.float32)

    x = jax.random.normal(next(keys), (BATCH, SEQ, D_MODEL), jnp.float32)
    return {
        "x": x,
        "attn_norm_g": gain((D_MODEL,)),
        "w_in": w((D_MODEL, D_IN), D_MODEL),
        "mla_q_lat_g": gain((MLA_Q_RANK,)),
        "mla_kv_lat_g": gain((MLA_KV_RANK,)),
        "mla_w_uq": w((MLA_Q_RANK, MLA_HEADS * MLA_QK), MLA_Q_RANK),
        "mla_w_uk": w((MLA_KV_RANK, MLA_HEADS * MLA_NOPE), MLA_KV_RANK),
        "mla_w_uv": w((MLA_KV_RANK, MLA_HEADS * MLA_V), MLA_KV_RANK),
        "mla_q_norm_g": gain((MLA_QK,)),
        "mla_k_norm_g": gain((MLA_QK,)),
        "nsa_q_norm_g": gain((NSA_DK,)),
        "nsa_k_norm_g": gain((3, NSA_DK)),
        "cmp_pe_k": small((CMP_LEN, NSA_DK), 0.1),
        "cmp_pe_v": small((CMP_LEN, NSA_DV), 0.1),
        "cmp_k_w1": w((CMP_LEN * NSA_DK, CMP_HIDDEN_K), CMP_LEN * NSA_DK),
        "cmp_k_b1": small((CMP_HIDDEN_K,), 0.01),
        "cmp_k_w2": w((CMP_HIDDEN_K, NSA_DK), CMP_HIDDEN_K),
        "cmp_k_b2": small((NSA_DK,), 0.01),
        "cmp_v_w1": w((CMP_LEN * NSA_DV, CMP_HIDDEN_V), CMP_LEN * NSA_DV),
        "cmp_v_b1": small((CMP_HIDDEN_V,), 0.01),
        "cmp_v_w2": w((CMP_HIDDEN_V, NSA_DV), CMP_HIDDEN_V),
        "cmp_v_b2": small((NSA_DV,), 0.01),
        "w_proj_mla": w((MLA_HEADS * MLA_V, D_MODEL), MLA_HEADS * MLA_V),
        "w_proj_nsa": w((NSA_HEADS * NSA_DV, D_MODEL), NSA_HEADS * NSA_DV),
        "w_out": w((D_MODEL, D_MODEL), D_MODEL),
        "ffn_norm_g": gain((D_MODEL,)),
        "w_ffn_gate": w((D_MODEL, D_FF), D_MODEL),
        "w_ffn_up": w((D_MODEL, D_FF), D_MODEL),
        "w_ffn_down": w((D_FF, D_MODEL), D_FF),
    }


def reference(x, attn_norm_g, w_in, mla_q_lat_g, mla_kv_lat_g, mla_w_uq, mla_w_uk, mla_w_uv,
              mla_q_norm_g, mla_k_norm_g, nsa_q_norm_g, nsa_k_norm_g, cmp_pe_k, cmp_pe_v,
              cmp_k_w1, cmp_k_b1, cmp_k_w2, cmp_k_b2, cmp_v_w1, cmp_v_b1, cmp_v_w2, cmp_v_b2,
              w_proj_mla, w_proj_nsa, w_out, ffn_norm_g, w_ffn_gate, w_ffn_up, w_ffn_down):
    h = x
    for l in range(DEPTH):
        h = hybrid_layer(h, attn_norm_g[l], w_in[l], mla_q_lat_g[l], mla_kv_lat_g[l], mla_w_uq[l],
                         mla_w_uk[l], mla_w_uv[l], mla_q_norm_g[l], mla_k_norm_g[l], nsa_q_norm_g[l],
                         nsa_k_norm_g[l], cmp_pe_k[l], cmp_pe_v[l], cmp_k_w1[l], cmp_k_b1[l], cmp_k_w2[l],
                         cmp_k_b2[l], cmp_v_w1[l], cmp_v_b1[l], cmp_v_w2[l], cmp_v_b2[l], w_proj_mla[l],
                         w_proj_nsa[l], w_out[l], ffn_norm_g[l], w_ffn_gate[l], w_ffn_up[l], w_ffn_down[l])
    return h
```

```cpp
#include <hip/hip_runtime.h>
#include <hip/hip_bf16.h>
#include <hip/hip_cooperative_groups.h>
#include <cstdio>
namespace cg = cooperative_groups;

typedef __attribute__((ext_vector_type(8))) short bf16x8;
typedef __attribute__((ext_vector_type(16))) float f32x16;
typedef unsigned short u16;

#define NTOK 16384
#define SEQ 2048
#define LOG2E 1.4426950408889634f
#define MIB (1ull << 20)

#ifndef DEBUG_CHECKS
#define DEBUG_CHECKS 0
#endif

#define OFF_RSTD_X   (0)
#define OFF_RSTD_CQ  (65536)
#define OFF_RSTD_CKV (131072)
#define OFF_RSTD_H   (196608)
#define OFF_COSM     (262144)
#define OFF_SINM     (524288)
#define OFF_COSN     (786432)
#define OFF_SINN     (983040)
#define OFF_BPART    (5 * MIB)
#define OFF_BIAS1    (1179648)
#define OFF_DIAG     (1184768)
#define OFF_SSPART   (6 * MIB)
#define OFF_BAR      (7 * MIB)
#define OFF_GATES    (2 * MIB)
#define OFF_WT_IN    (8 * MIB)
#define OFF_WT_UQ    (56 * MIB)
#define OFF_WT_UKV   (59 * MIB)
#define OFF_WT_CK1   (63 * MIB)
#define OFF_WT_CV1   (72 * MIB)
#define OFF_WT_CK2   (76 * MIB)
#define OFF_WT_CV2   (76 * MIB + 512 * 1024)
#define OFF_WT_PM    (77 * MIB)
#define OFF_WT_PN    (85 * MIB)
#define OFF_WT_O     (93 * MIB)
#define ACT          (101 * MIB)
#define OFF_XB       (ACT + 0 * MIB)
#define OFF_LAT      (ACT + 64 * MIB)
#define OFF_KM       (ACT + 104 * MIB)
#define OFF_VTM      (ACT + 200 * MIB)
#define OFF_OMLA     (ACT + 264 * MIB)
#define OFF_QN       (ACT + 64 * MIB)
#define OFF_KC       (ACT + 160 * MIB)
#define OFF_KS       (ACT + 184 * MIB)
#define OFF_KW       (ACT + 208 * MIB)
#define OFF_VC       (ACT + 232 * MIB)
#define OFF_VST      (ACT + 248 * MIB)
#define OFF_VWT      (ACT + 328 * MIB)
#define OFF_HK       (ACT + 344 * MIB)
#define OFF_HV       (ACT + 350 * MIB)
#define OFF_KCRAW    (ACT + 354 * MIB)
#define OFF_VCT      (ACT + 357 * MIB)
#define OFF_KCN      (ACT + 358 * MIB)
#define OFF_PARTK    (ACT + 0 * MIB)
#define OFF_PARTV    (ACT + 48 * MIB)
#define OFF_ONSA     (ACT + 0 * MIB)
#define OFF_M        (ACT + 64 * MIB)
#define OFF_HB       (ACT + 344 * MIB)
#define OFF_WT_GU    (ACT + 264 * MIB)
#define OFF_WT_D     (ACT + 308 * MIB)
#define OFF_ACTF     (ACT + 0 * MIB)

struct Params {
  const float* in[29];
  float* out;
  char* ws;
  int phase_lo, phase_hi;
};

__device__ __forceinline__ u16 f2bf(float f) {
  unsigned u = __float_as_uint(f);
  u += 0x7fffu + ((u >> 16) & 1u);
  return (u16)(u >> 16);
}
__device__ __forceinline__ float bf2f(u16 b) { return __uint_as_float(((unsigned)b) << 16); }
typedef __bf16 bf16x2_t __attribute__((ext_vector_type(2)));
typedef float float2_t __attribute__((ext_vector_type(2)));
__device__ __forceinline__ unsigned pack2(float a, float b) {
  float2_t f = {a, b};
  bf16x2_t h = __builtin_convertvector(f, bf16x2_t);
  return __builtin_bit_cast(unsigned, h);
}
__device__ __forceinline__ float sigmoidf_(float x) { return 1.f / (1.f + __expf(-x)); }
__device__ __forceinline__ float wave_sum(float v) {
  v += __shfl_xor(v, 32); v += __shfl_xor(v, 16); v += __shfl_xor(v, 8);
  v += __shfl_xor(v, 4); v += __shfl_xor(v, 2); v += __shfl_xor(v, 1);
  return v;
}
__device__ __forceinline__ float half_sum(float v) {
  v += __shfl_xor(v, 16); v += __shfl_xor(v, 8);
  v += __shfl_xor(v, 4); v += __shfl_xor(v, 2); v += __shfl_xor(v, 1);
  return v;
}
typedef float f4_t __attribute__((ext_vector_type(4)));
__device__ __forceinline__ float4 ld_nt4(const float* p) {
  f4_t v = __builtin_nontemporal_load((const f4_t*)p);
  return make_float4(v.x, v.y, v.z, v.w);
}
__device__ __forceinline__ void st_nt4(float* p, float a, float b, float c, float d) {
  f4_t v = {a, b, c, d};
  __builtin_nontemporal_store(v, (f4_t*)p);
}
__device__ __forceinline__ int vpos(int t) {
  return (t & ~15) | (((t >> 2) & 1) << 3) | (((t >> 3) & 1) << 2) | (t & 3);
}

__device__ __forceinline__ void rows_to_bf16(const float* __restrict__ x, u16* __restrict__ xb, float* __restrict__ rstd) {
  const int lane = threadIdx.x & 63;
  const int wave = (blockIdx.x * 512 + threadIdx.x) >> 6, nw = gridDim.x * 8;
  for (int row = wave; row < NTOK; row += nw) {
    const float4* src = (const float4*)(x + (long)row * 2048);
    uint2* dst = (uint2*)(xb + (long)row * 2048);
    float ss = 0.f;
#pragma unroll
    for (int i = 0; i < 8; ++i) {
      float4 v = ld_nt4((const float*)(src + lane + i * 64));
      ss += v.x * v.x + v.y * v.y + v.z * v.z + v.w * v.w;
      uint2 o; o.x = pack2(v.x, v.y); o.y = pack2(v.z, v.w);
      dst[lane + i * 64] = o;
    }
    ss = wave_sum(ss);
    if (lane == 0) rstd[row] = rsqrtf(ss * (1.f / 2048.f) + 1e-6f);
  }
}

template <int MODE>
__device__ __forceinline__ void transpose_convert(char* smem, const float* __restrict__ src, int ldsrc, int K, int col0, int ncols,
                                  u16* __restrict__ dst, long ldd, int dst_row0, const float* __restrict__ gain,
                                  int bidx = -1, int bcnt = 0) {
  float* tile = (float*)smem;
  const int tid = threadIdx.x;
  const int ntn = (ncols + 255) >> 8, ntk = K >> 6;
  if (bidx < 0) { bidx = blockIdx.x; bcnt = gridDim.x; }
  for (int t = bidx; t < ntn * ntk; t += bcnt) {
    const int tn = t % ntn, tk = t / ntn;
    const int k0 = tk * 64, n0 = tn * 256;
    const int c4 = (tid & 63) * 4;
    float4 v[8];
#pragma unroll
    for (int i = 0; i < 8; ++i) {
      int kk = (tid >> 6) + i * 8;
      v[i] = make_float4(0.f, 0.f, 0.f, 0.f);
      if (n0 + c4 < ncols) v[i] = ld_nt4(src + (long)(k0 + kk) * ldsrc + col0 + n0 + c4);
    }
#pragma unroll
    for (int i = 0; i < 8; ++i) {
      int kk = (tid >> 6) + i * 8;
      float gv = gain ? gain[k0 + kk] : 1.f;
      tile[kk * 257 + c4] = v[i].x * gv; tile[kk * 257 + c4 + 1] = v[i].y * gv;
      tile[kk * 257 + c4 + 2] = v[i].z * gv; tile[kk * 257 + c4 + 3] = v[i].w * gv;
    }
    __syncthreads();
    {
      int nn = tid >> 1, kh = (tid & 1) * 32;
      if (n0 + nn < ncols) {
        int n = n0 + nn;
        int drow = (MODE == 0) ? (dst_row0 + n) : ((n >> 7) * 256 + (n & 127) + (MODE == 2 ? 128 : 0));
        u16* dp = dst + (long)drow * ldd + k0 + kh;
#pragma unroll
        for (int q = 0; q < 4; ++q) {
          uint4 o;
          o.x = pack2(tile[(kh + q * 8 + 0) * 257 + nn], tile[(kh + q * 8 + 1) * 257 + nn]);
          o.y = pack2(tile[(kh + q * 8 + 2) * 257 + nn], tile[(kh + q * 8 + 3) * 257 + nn]);
          o.z = pack2(tile[(kh + q * 8 + 4) * 257 + nn], tile[(kh + q * 8 + 5) * 257 + nn]);
          o.w = pack2(tile[(kh + q * 8 + 6) * 257 + nn], tile[(kh + q * 8 + 7) * 257 + nn]);
          *(uint4*)(dp + q * 8) = o;
        }
      }
    }
    __syncthreads();
  }
}

__device__ __forceinline__ void zero_fill16(char* p, long bytes) {
  long n = bytes >> 4;
  long tid = (long)blockIdx.x * 512 + threadIdx.x, nth = (long)gridDim.x * 512;
  uint4 z = make_uint4(0, 0, 0, 0);
  for (long i = tid; i < n; i += nth) ((uint4*)p)[i] = z;
}

__device__ __forceinline__ void phase_prep(const Params& p, char* smem) {
  char* ws = p.ws;
  rows_to_bf16(p.in[0], (u16*)(ws + OFF_XB), (float*)(ws + OFF_RSTD_X));
  u16* wtin = (u16*)(ws + OFF_WT_IN);
  const float* w_in = p.in[2];
  transpose_convert<0>(smem, w_in, 12144, 2048, 0, 1088, wtin, 2048, 0, p.in[1]);
  transpose_convert<0>(smem, w_in, 12144, 2048, 8000, 48, wtin, 2048, 1088, p.in[1]);
  zero_fill16((char*)(wtin + (long)1136 * 2048), (long)144 * 2048 * 2);
  transpose_convert<0>(smem, w_in, 12144, 2048, 1088, 5120, wtin, 2048, 1280, p.in[1]);
  transpose_convert<0>(smem, w_in, 12144, 2048, 6720, 768, wtin, 2048, 6400, p.in[1]);
  transpose_convert<0>(smem, w_in, 12144, 2048, 6208, 512, wtin, 2048, 7168, p.in[1]);
  transpose_convert<0>(smem, w_in, 12144, 2048, 7488, 512, wtin, 2048, 7680, p.in[1]);
  transpose_convert<0>(smem, w_in, 12144, 2048, 8048, 4096, wtin, 2048, 8192, p.in[1]);
  transpose_convert<0>(smem, p.in[5], 3072, 512, 0, 3072, (u16*)(ws + OFF_WT_UQ), 512, 0, p.in[3]);
  transpose_convert<0>(smem, p.in[6], 2048, 512, 0, 2048, (u16*)(ws + OFF_WT_UKV), 512, 0, p.in[4]);
  transpose_convert<0>(smem, p.in[7], 2048, 512, 0, 2048, (u16*)(ws + OFF_WT_UKV), 512, 2048, p.in[4]);
  transpose_convert<0>(smem, p.in[16], 192, 768, 0, 192, (u16*)(ws + OFF_WT_CK2), 768, 0, nullptr);
  zero_fill16(ws + OFF_WT_CK2 + (long)192 * 768 * 2, (long)64 * 768 * 2);
  transpose_convert<0>(smem, p.in[20], 128, 512, 0, 128, (u16*)(ws + OFF_WT_CV2), 512, 0, nullptr);
  zero_fill16(ws + OFF_WT_CV2 + (long)128 * 512 * 2, (long)128 * 512 * 2);
  {
    float* cosm = (float*)(ws + OFF_COSM); float* sinm = (float*)(ws + OFF_SINM);
    float* cosn = (float*)(ws + OFF_COSN); float* sinn = (float*)(ws + OFF_SINN);
    long tid = (long)blockIdx.x * 512 + threadIdx.x, nth = (long)gridDim.x * 512;
    for (long i = tid; i < 2048 * 32; i += nth) {
      int t = (int)(i >> 5), k = (int)(i & 31);
      double inv = exp2(-(double)k / 32.0 * 18.931568569324174);
      double a = (double)t * inv;
      cosm[i] = (float)cos(a); sinm[i] = (float)sin(a);
    }
    for (long i = tid; i < 2048 * 24; i += nth) {
      int t = (int)(i / 24), k = (int)(i % 24);
      double inv = exp2(-(double)k / 24.0 * 18.931568569324174);
      double a = (double)t * inv;
      cosn[i] = (float)cos(a); sinn[i] = (float)sin(a);
    }
  }
  {
    float* part = (float*)(ws + OFF_BPART);
    for (int job = blockIdx.x; job < 256; job += gridDim.x) {
      int which = job >> 7, kc = job & 127;
      int Kd = which ? 4096 : 6144, N = which ? 512 : 768;
      const float* pe = which ? p.in[13] : p.in[12];
      const float* w1 = which ? p.in[18] : p.in[14];
      int klen = Kd / 128;
      for (int n = threadIdx.x; n < N; n += 512) {
        float s = 0.f;
#pragma unroll 8
        for (int k = kc * klen; k < (kc + 1) * klen; ++k) s += pe[k] * w1[(long)k * N + n];
        part[kc * 1280 + which * 768 + n] = s;
      }
    }
  }
}

template <class AF, class EP>
__device__ __forceinline__ void gemm_tile(char* smem, AF aptr, const u16* __restrict__ Bt, long ldb, int K, int row0,
                                          int col0, EP& epi) {
  const int tid = threadIdx.x, lane = tid & 63, wid = tid >> 6;
  const int wm = wid >> 1, wn = wid & 1, l31 = lane & 31, hh = lane >> 5;
  f32x16 acc[2][2];
#pragma unroll
  for (int i = 0; i < 2; ++i)
#pragma unroll
    for (int j = 0; j < 2; ++j)
#pragma unroll
      for (int r = 0; r < 16; ++r) acc[i][j][r] = 0.f;
  uint4 ra[4], rb[2];
  const int nk = K >> 6;
  const int sr = tid >> 3, sc = tid & 7;
  const int swz = (sc ^ ((sr >> 1) & 7)) << 4;
  auto gload = [&](int kt) {
#pragma unroll
    for (int i = 0; i < 4; ++i) ra[i] = *(const uint4*)(aptr(row0 + sr + i * 64, kt * 64 + sc * 8));
#pragma unroll
    for (int i = 0; i < 2; ++i) rb[i] = *(const uint4*)(Bt + (long)(col0 + sr + i * 64) * ldb + kt * 64 + sc * 8);
  };
  auto lstore = [&](int buf) {
    char* As = smem + buf * 49152;
    char* Bs = As + 32768;
#pragma unroll
    for (int i = 0; i < 4; ++i) *(uint4*)(As + (sr + i * 64) * 128 + swz) = ra[i];
#pragma unroll
    for (int i = 0; i < 2; ++i) *(uint4*)(Bs + (sr + i * 64) * 128 + swz) = rb[i];
  };
  gload(0);
  lstore(0);
  __syncthreads();
  for (int kt = 0; kt < nk; ++kt) {
    if (kt + 1 < nk) gload(kt + 1);
    const char* As = smem + (kt & 1) * 49152;
    const char* Bs = As + 32768;
#pragma unroll
    for (int ks = 0; ks < 4; ++ks) {
      bf16x8 a[2], b[2];
#pragma unroll
      for (int i = 0; i < 2; ++i) {
        int r = wm * 64 + i * 32 + l31, c = ks * 2 + hh;
        a[i] = *(const bf16x8*)(As + r * 128 + ((c ^ ((r >> 1) & 7)) << 4));
      }
#pragma unroll
      for (int j = 0; j < 2; ++j) {
        int r = wn * 64 + j * 32 + l31, c = ks * 2 + hh;
        b[j] = *(const bf16x8*)(Bs + r * 128 + ((c ^ ((r >> 1) & 7)) << 4));
      }
#pragma unroll
      for (int i = 0; i < 2; ++i)
#pragma unroll
        for (int j = 0; j < 2; ++j) acc[i][j] = __builtin_amdgcn_mfma_f32_32x32x16_bf16(a[i], b[j], acc[i][j], 0, 0, 0);
    }
    if (kt + 1 < nk) lstore((kt + 1) & 1);
    __syncthreads();
  }
  epi(acc, row0 + wm * 64 + 4 * hh, col0 + wn * 64 + l31, col0);
}

template <class AF, class EP>
__device__ __forceinline__ void gemm_phase(char* smem, AF aptr, const u16* Bt, long ldb, int M, int N, int K, EP epi) {
  const int MT = M >> 8, NT = N >> 7;
  for (int t = blockIdx.x; t < MT * NT; t += gridDim.x) {
    int nt = t % NT, mt = t / NT;
    gemm_tile(smem, aptr, Bt, ldb, K, mt * 256, nt * 128, epi);
  }
}

struct ARow {
  const u16* A; long lda;
  __device__ __forceinline__ const u16* operator()(int row, int k) const { return A + (long)row * lda + k; }
  __device__ __forceinline__ unsigned rowoff(int row) const { return (unsigned)(row * (int)lda); }
  __device__ __forceinline__ long koff(int kt) const { return (long)kt * 64; }
};
template <int DH, int LD>
struct ACmp {
  const u16* A;
  __device__ __forceinline__ const u16* operator()(int row, int k) const {
    int bg = row >> 7, c = row & 127, b = bg >> 2, g = bg & 3;
    int j = k / DH, d = k - j * DH;
    int tok = 16 * c + j; if (tok > 2047) tok = 2047;
    return A + ((long)(b * 2048 + tok)) * LD + g * DH + d;
  }
  __device__ __forceinline__ unsigned rowoff(int row) const {
    int bg = row >> 7, c = row & 127, b = bg >> 2, g = bg & 3;
    return (unsigned)((b * 2048 + 16 * c) * LD + g * DH);
  }
  __device__ __forceinline__ long koff(int kt) const {
    int k = kt * 64; int j = k / DH;
    return (long)j * LD + (k - j * DH);
  }
};

struct ACmpU {
  const u16* A; int LD, DH, isV;
  __device__ __forceinline__ unsigned rowoff(int row) const {
    int bg = row >> 7, c = row & 127, b = bg >> 2, g = bg & 3;
    return (unsigned)((b * 2048 + 16 * c) * LD + g * DH);
  }
  __device__ __forceinline__ long koff(int kt) const {
    int j = isV ? (kt >> 1) : ((kt * 43) >> 7);
    int rem = kt - j * (isV ? 2 : 3);
    return (long)j * LD + rem * 64;
  }
};
#define EPI_ITER for (int i = 0; i < 2; ++i) for (int j = 0; j < 2; ++j) for (int rg = 0; rg < 4; ++rg)

struct EpLat {
  u16* lat; float* gates; const float* rstd;
  __device__ __forceinline__ void operator()(f32x16 (&acc)[2][2], int rb, int cb, int col0) const {
#pragma unroll
    EPI_ITER {
      int col = cb + j * 32;
#pragma unroll
      for (int e = 0; e < 4; ++e) {
        int row = rb + i * 32 + 8 * rg + e;
        float v = acc[i][j][rg * 4 + e] * rstd[row];
        if (col < 1088) lat[(long)row * 1280 + col] = f2bf(v);
        else if (col < 1136) gates[(long)row * 48 + (col - 1088)] = sigmoidf_(v);
      }
    }
  }
};
__device__ __forceinline__ void store_T4(u16* base, long ld, int dv, int row, float v0, float v1, float v2, float v3) {
  int t = row & 2047;
  uint2 o; o.x = pack2(v0, v1); o.y = pack2(v2, v3);
  *(uint2*)(base + (long)dv * ld + vpos(t)) = o;
}
struct EpNsa {
  char* ws; const float* rstd;
  __device__ __forceinline__ void operator()(f32x16 (&acc)[2][2], int rb, int cb, int col0) const {
    u16* rm; int ld, cbase; bool tr = false; u16* tb = nullptr;
    if (col0 < 3072) { rm = (u16*)(ws + OFF_QN); ld = 3072; cbase = 0; }
    else if (col0 < 3840) { rm = (u16*)(ws + OFF_KC); ld = 768; cbase = 3072; }
    else if (col0 < 4352) { rm = (u16*)(ws + OFF_VC); ld = 512; cbase = 3840; }
    else if (col0 < 5120) { rm = (u16*)(ws + OFF_KS); ld = 768; cbase = 4352; }
    else if (col0 < 5632) { tr = true; tb = (u16*)(ws + OFF_VST); rm = nullptr; ld = 0; cbase = 5120; }
    else if (col0 < 6400) { rm = (u16*)(ws + OFF_KW); ld = 768; cbase = 5632; }
    else { tr = true; tb = (u16*)(ws + OFF_VWT); rm = nullptr; ld = 0; cbase = 6400; }
#pragma unroll
    EPI_ITER {
      int col = cb + j * 32 - cbase;
      int row = rb + i * 32 + 8 * rg;
      float v0 = acc[i][j][rg * 4 + 0] * rstd[row], v1 = acc[i][j][rg * 4 + 1] * rstd[row + 1];
      float v2 = acc[i][j][rg * 4 + 2] * rstd[row + 2], v3 = acc[i][j][rg * 4 + 3] * rstd[row + 3];
      if (tr) {
        int b = row >> 11, g = col >> 7, dv = col & 127;
        store_T4(tb + (long)(b * 4 + g) * 128 * 2048, 2048, dv, row, v0, v1, v2, v3);
      } else {
        rm[(long)row * ld + col] = f2bf(v0); rm[(long)(row + 1) * ld + col] = f2bf(v1);
        rm[(long)(row + 2) * ld + col] = f2bf(v2); rm[(long)(row + 3) * ld + col] = f2bf(v3);
      }
    }
  }
};
struct EpGm {
  u16* gm; const float* rstd;
  __device__ __forceinline__ void operator()(f32x16 (&acc)[2][2], int rb, int cb, int col0) const {
#pragma unroll
    EPI_ITER {
#pragma unroll
      for (int e = 0; e < 4; ++e) {
        int row = rb + i * 32 + 8 * rg + e, col = cb + j * 32;
        gm[(long)row * 4096 + col] = f2bf(sigmoidf_(acc[i][j][rg * 4 + e] * rstd[row]));
      }
    }
  }
};
struct EpQ {
  u16* q; const float* rstd;
  __device__ __forceinline__ void operator()(f32x16 (&acc)[2][2], int rb, int cb, int col0) const {
#pragma unroll
    EPI_ITER {
#pragma unroll
      for (int e = 0; e < 4; ++e) {
        int row = rb + i * 32 + 8 * rg + e, col = cb + j * 32;
        q[(long)row * 3072 + col] = f2bf(acc[i][j][rg * 4 + e] * rstd[row]);
      }
    }
  }
};
struct EpKV {
  u16* km; u16* vtm; const float* rstd;
  __device__ __forceinline__ void operator()(f32x16 (&acc)[2][2], int rb, int cb, int col0) const {
#pragma unroll
    EPI_ITER {
      int col = cb + j * 32;
      int row = rb + i * 32 + 8 * rg;
      float v0 = acc[i][j][rg * 4 + 0] * rstd[row], v1 = acc[i][j][rg * 4 + 1] * rstd[row + 1];
      float v2 = acc[i][j][rg * 4 + 2] * rstd[row + 2], v3 = acc[i][j][rg * 4 + 3] * rstd[row + 3];
      if (col0 < 2048) {
        int h = col >> 7, d = col & 127;
        long o = (long)row * 3072 + h * 192 + d;
        km[o] = f2bf(v0); km[o + 3072] = f2bf(v1); km[o + 6144] = f2bf(v2); km[o + 9216] = f2bf(v3);
      } else {
        int c = col - 2048, h = c >> 7, dv = c & 127, b = row >> 11;
        store_T4(vtm + (long)(b * 16 + h) * 128 * 2048, 2048, dv, row, v0, v1, v2, v3);
      }
    }
  }
};
__device__ __forceinline__ float gelu_tanh(float x) {
  float u = 0.7978845608028654f * (x + 0.044715f * x * x * x);
  float t = 1.f - 2.f / (1.f + __expf(2.f * u));
  return 0.5f * x * (1.f + t);
}
struct EpCmp1 {
  u16* h; int ld; const float* bias;
  __device__ __forceinline__ void operator()(f32x16 (&acc)[2][2], int rb, int cb, int col0) const {
#pragma unroll
    EPI_ITER {
      int col = cb + j * 32;
      float bv = bias[col];
#pragma unroll
      for (int e = 0; e < 4; ++e) {
        int row = rb + i * 32 + 8 * rg + e;
        h[(long)row * ld + col] = f2bf(gelu_tanh(acc[i][j][rg * 4 + e] + bv));
      }
    }
  }
};
struct EpCmp2K {
  float* kraw; const float* b2;
  __device__ __forceinline__ void operator()(f32x16 (&acc)[2][2], int rb, int cb, int col0) const {
#pragma unroll
    EPI_ITER {
      int col = cb + j * 32;
      if (col < 192) {
        float bv = b2[col];
#pragma unroll
        for (int e = 0; e < 4; ++e) {
          int row = rb + i * 32 + 8 * rg + e;
          kraw[(long)row * 192 + col] = acc[i][j][rg * 4 + e] + bv;
        }
      }
    }
  }
};
struct EpCmp2V {
  u16* vct; const float* b2;
  __device__ __forceinline__ void operator()(f32x16 (&acc)[2][2], int rb, int cb, int col0) const {
#pragma unroll
    EPI_ITER {
      int dv = cb + j * 32;
      int row = rb + i * 32 + 8 * rg;
      float bv = b2[dv];
      int bg = row >> 7, c = row & 127;
      uint2 o; o.x = pack2(acc[i][j][rg * 4 + 0] + bv, acc[i][j][rg * 4 + 1] + bv);
      o.y = pack2(acc[i][j][rg * 4 + 2] + bv, acc[i][j][rg * 4 + 3] + bv);
      *(uint2*)(vct + ((long)bg * 128 + dv) * 128 + vpos(c)) = o;
    }
  }
};
template <int MODE>
struct EpY {
  u16* m; const u16* gm;
  __device__ __forceinline__ void operator()(f32x16 (&acc)[2][2], int rb, int cb, int col0) const {
#pragma unroll
    EPI_ITER {
#pragma unroll
      for (int e = 0; e < 4; ++e) {
        int row = rb + i * 32 + 8 * rg + e, col = cb + j * 32;
        float v = bf2f(gm[(long)row * 4096 + MODE * 2048 + col]) * acc[i][j][rg * 4 + e];
        if (MODE == 1) v += bf2f(m[(long)row * 2048 + col]);
        m[(long)row * 2048 + col] = f2bf(v);
      }
    }
  }
};
struct EpOut {
  float* out; const float* x;
  __device__ __forceinline__ void operator()(f32x16 (&acc)[2][2], int rb, int cb, int col0) const {
#pragma unroll
    EPI_ITER {
#pragma unroll
      for (int e = 0; e < 4; ++e) {
        long o = (long)(rb + i * 32 + 8 * rg + e) * 2048 + cb + j * 32;
        out[o] = x[o] + acc[i][j][rg * 4 + e];
      }
    }
  }
};
struct EpFfn1 {
  u16* act; const float* rstd;
  __device__ __forceinline__ void operator()(f32x16 (&acc)[2][2], int rb, int cb, int col0) const {
    int u = (col0 >> 7) * 64 + ((cb - col0) >> 6) * 32 + ((cb - col0) & 31);
#pragma unroll
    for (int i = 0; i < 2; ++i)
#pragma unroll
      for (int rg = 0; rg < 4; ++rg)
#pragma unroll
        for (int e = 0; e < 4; ++e) {
          int row = rb + i * 32 + 8 * rg + e;
          float rs = rstd[row];
          float g = acc[i][0][rg * 4 + e] * rs, up = acc[i][1][rg * 4 + e] * rs;
          act[(long)row * 5632 + u] = f2bf(g * sigmoidf_(g) * up);
        }
  }
};
struct EpFfn2 {
  float* out;
  __device__ __forceinline__ void operator()(f32x16 (&acc)[2][2], int rb, int cb, int col0) const {
#pragma unroll
    EPI_ITER {
#pragma unroll
      for (int e = 0; e < 4; ++e) {
        long o = (long)(rb + i * 32 + 8 * rg + e) * 2048 + cb + j * 32;
        out[o] = out[o] + acc[i][j][rg * 4 + e];
      }
    }
  }
};

typedef __attribute__((ext_vector_type(4))) float f32x4;
#define G8_HT 8192
__device__ __forceinline__ int g8_lds_byte(int r, int c) {
  int st = (r >> 4) * 2 + (c >> 5), rr = r & 15, cc = c & 31, ob = rr * 64 + cc * 2;
  return st * 1024 + (ob ^ (((ob >> 9) & 1) << 5));
}
__device__ __forceinline__ void g8_stage_rc(int b, int& R, int& C) {
  int st = b / 1024, sb = b % 1024, swz = sb ^ (((sb >> 9) & 1) << 5);
  R = (st >> 1) * 16 + swz / 64; C = (st & 1) * 32 + (swz % 64) / 2;
}

__device__ __forceinline__ const char* uniform_ptr(const char* p) {
  unsigned long long v = (unsigned long long)p;
  unsigned lo = __builtin_amdgcn_readfirstlane((unsigned)v), hi = __builtin_amdgcn_readfirstlane((unsigned)(v >> 32));
  return (const char*)(((unsigned long long)hi << 32) | lo);
}
template <class AF, class EP>
__device__ __forceinline__ void gemm8_tile(char* smem, AF aptr, const u16* __restrict__ Bt, long ldb, int ktb, int nt,
                                           int brow, int bcol, EP& epi) {
  u16* shm = (u16*)smem;
#define SA(b, h) (shm + ((b) * 2 + (h)) * G8_HT)
#define SB(b, h) (shm + (4 + (b) * 2 + (h)) * G8_HT)
#define STAGE_A(P, hf, kt) do { const char* ab_ = uniform_ptr((const char*)(aptr.A + aptr.koff((kt) + ktb))); \
    __builtin_amdgcn_global_load_lds((const unsigned*)(ab_ + aoff[hf][0]), (unsigned*)((char*)(P) + sb0), 16, 0, 0); \
    __builtin_amdgcn_global_load_lds((const unsigned*)(ab_ + aoff[hf][1]), (unsigned*)((char*)(P) + sb0 + 8192), 16, 0, 0); } while (0)
#define STAGE_B(P, hf, kt) do { const char* bb_ = uniform_ptr((const char*)(Bt + (long)(bcol + (hf) * 128) * ldb + (long)((kt) + ktb) * 64)); \
    __builtin_amdgcn_global_load_lds((const unsigned*)(bb_ + boff0), (unsigned*)((char*)(P) + sb0), 16, 0, 0); \
    __builtin_amdgcn_global_load_lds((const unsigned*)(bb_ + boff1), (unsigned*)((char*)(P) + sb0 + 8192), 16, 0, 0); } while (0)
#define LDA(dst, b, h) for (int m = 0; m < 4; ++m) for (int k = 0; k < 2; ++k) \
    dst[m][k] = *reinterpret_cast<const bf16x8*>((char*)SA(b, h) + g8_lds_byte(wr * 64 + m * 16 + fr, k * 32 + fq * 8))
#define LDB(dst, b, h) for (int n = 0; n < 2; ++n) for (int k = 0; k < 2; ++k) \
    dst[n][k] = *reinterpret_cast<const bf16x8*>((char*)SB(b, h) + g8_lds_byte(wc * 32 + n * 16 + fr, k * 32 + fq * 8))
#define MMA(ai, bj, At_, Bt_) do { __builtin_amdgcn_s_setprio(1); \
    for (int m = 0; m < 4; ++m) for (int n = 0; n < 2; ++n) for (int k = 0; k < 2; ++k) \
      acc[ai][bj][m][n] = __builtin_amdgcn_mfma_f32_16x16x32_bf16(At_[m][k], Bt_[n][k], acc[ai][bj][m][n], 0, 0, 0); \
    __builtin_amdgcn_s_setprio(0); } while (0)
#define WAIT_V(n) asm volatile("s_waitcnt vmcnt(" #n ")" ::: "memory")
#define WAIT_L(n) asm volatile("s_waitcnt lgkmcnt(" #n ")" ::: "memory")
#define BAR __builtin_amdgcn_s_barrier()
#define SCHED __builtin_amdgcn_sched_barrier(0)
  const int HALF = 128;
  int tid = threadIdx.x;
  asm volatile("" : "+v"(tid));
  const int wid = tid >> 6, lane = tid & 63, wr = wid >> 2, wc = wid & 3, fr = lane & 15, fq = lane >> 4;
  const int sb0 = tid * 16;
  int sR0, sC0, sR1, sC1;
  g8_stage_rc(sb0, sR0, sC0);
  g8_stage_rc(sb0 + 8192, sR1, sC1);
  unsigned aoff[2][2];
  aoff[0][0] = (aptr.rowoff(brow + sR0) + sC0) * 2u; aoff[0][1] = (aptr.rowoff(brow + sR1) + sC1) * 2u;
  aoff[1][0] = (aptr.rowoff(brow + 128 + sR0) + sC0) * 2u; aoff[1][1] = (aptr.rowoff(brow + 128 + sR1) + sC1) * 2u;
  const unsigned boff0 = (unsigned)(sR0 * (int)ldb + sC0) * 2u, boff1 = (unsigned)(sR1 * (int)ldb + sC1) * 2u;
  f32x4 acc[2][2][4][2];
#pragma unroll
  for (int a = 0; a < 2; ++a)
#pragma unroll
    for (int b = 0; b < 2; ++b)
#pragma unroll
      for (int m = 0; m < 4; ++m)
#pragma unroll
        for (int n = 0; n < 2; ++n) acc[a][b][m][n] = f32x4{0.f, 0.f, 0.f, 0.f};
  bf16x8 At[4][2], B0[2][2], B1[2][2];
  STAGE_B(SB(0, 0), 0, 0); STAGE_A(SA(0, 0), 0, 0);
  STAGE_B(SB(0, 1), 1, 0); STAGE_A(SA(0, 1), 1, 0);
  if (wr == 1) BAR;
  WAIT_V(4); BAR;
  STAGE_B(SB(1, 0), 0, 1); STAGE_A(SA(1, 0), 0, 1); STAGE_B(SB(1, 1), 1, 1);
  WAIT_V(6); BAR;
  for (int t = 0; t < nt - 2; t += 2) {
#pragma unroll
    LDB(B0, 0, 0); SCHED;
#pragma unroll
    LDA(At, 0, 0); STAGE_A(SA(1, 1), 1, t + 1);
    WAIT_L(8); BAR; WAIT_L(0);
#pragma unroll
    MMA(0, 0, At, B0); BAR; SCHED;
#pragma unroll
    LDB(B1, 0, 1); STAGE_B(SB(0, 0), 0, t + 2);
    BAR; WAIT_L(0);
#pragma unroll
    MMA(0, 1, At, B1); BAR;
#pragma unroll
    LDA(At, 0, 1); STAGE_A(SA(0, 0), 0, t + 2);
    BAR; WAIT_L(0);
#pragma unroll
    MMA(1, 0, At, B0); BAR; SCHED;
    STAGE_B(SB(0, 1), 1, t + 2);
    WAIT_V(6); BAR;
#pragma unroll
    MMA(1, 1, At, B1); BAR;
#pragma unroll
    LDB(B0, 1, 0); SCHED;
#pragma unroll
    LDA(At, 1, 0); STAGE_A(SA(0, 1), 1, t + 2);
    WAIT_L(8); BAR; WAIT_L(0);
#pragma unroll
    MMA(0, 0, At, B0); BAR; SCHED;
#pragma unroll
    LDB(B1, 1, 1); STAGE_B(SB(1, 0), 0, t + 3);
    BAR; WAIT_L(0);
#pragma unroll
    MMA(0, 1, At, B1); BAR;
#pragma unroll
    LDA(At, 1, 1); STAGE_A(SA(1, 0), 0, t + 3);
    BAR; WAIT_L(0);
#pragma unroll
    MMA(1, 0, At, B0); BAR; SCHED;
    STAGE_B(SB(1, 1), 1, t + 3);
    WAIT_V(6); BAR;
#pragma unroll
    MMA(1, 1, At, B1); BAR;
  }
  {
#pragma unroll
    LDB(B0, 0, 0);
#pragma unroll
    LDA(At, 0, 0); STAGE_A(SA(1, 1), 1, nt - 1);
    BAR; WAIT_L(0);
#pragma unroll
    MMA(0, 0, At, B0); BAR;
#pragma unroll
    LDB(B1, 0, 1); BAR; WAIT_L(0);
#pragma unroll
    MMA(0, 1, At, B1); BAR;
#pragma unroll
    LDA(At, 0, 1); WAIT_V(4); BAR; WAIT_L(0);
#pragma unroll
    MMA(1, 0, At, B0);
#pragma unroll
    MMA(1, 1, At, B1); BAR;
  }
  {
#pragma unroll
    LDB(B0, 1, 0);
#pragma unroll
    LDA(At, 1, 0); WAIT_V(2); BAR; WAIT_L(0);
#pragma unroll
    MMA(0, 0, At, B0); BAR;
#pragma unroll
    LDB(B1, 1, 1); WAIT_V(0); BAR; WAIT_L(0);
#pragma unroll
    MMA(0, 1, At, B1); BAR;
#pragma unroll
    LDA(At, 1, 1); BAR; WAIT_L(0);
#pragma unroll
    MMA(1, 0, At, B0);
#pragma unroll
    MMA(1, 1, At, B1); BAR;
  }
  if (wr == 0) BAR;
  if constexpr (EP::kind == 2) {
    epi(acc, brow + wr * 64 + fq * 4, bcol + wc * 32 + fr, bcol);
  } else {
    float* T = (float*)smem;
#pragma unroll
    for (int ai = 0; ai < 2; ++ai) {
      __syncthreads();
#pragma unroll
      for (int bj = 0; bj < 2; ++bj)
#pragma unroll
        for (int m = 0; m < 4; ++m)
#pragma unroll
          for (int n = 0; n < 2; ++n)
#pragma unroll
            for (int j = 0; j < 4; ++j)
              T[(wr * 64 + m * 16 + fq * 4 + j) * 260 + bj * 128 + wc * 32 + n * 16 + fr] = acc[ai][bj][m][n][j];
      __syncthreads();
      if constexpr (EP::kind == 0) {
#pragma unroll
        for (int q = 0; q < 8; ++q) {
          int id = tid + q * 512, r = id >> 5, c8 = (id & 31) * 8;
          float4 a = *(const float4*)(T + r * 260 + c8), b = *(const float4*)(T + r * 260 + c8 + 4);
          float v[8] = {a.x, a.y, a.z, a.w, b.x, b.y, b.z, b.w};
          epi.row8(brow + ai * 128 + r, bcol + c8, bcol, v);
        }
      } else {
#pragma unroll
        for (int q = 0; q < 4; ++q) {
          int id = tid + q * 512, r = id >> 4, c8 = (id & 15) * 8;
          float4 a = *(const float4*)(T + r * 260 + c8), b = *(const float4*)(T + r * 260 + c8 + 4);
          float4 c = *(const float4*)(T + r * 260 + 128 + c8), d = *(const float4*)(T + r * 260 + 128 + c8 + 4);
          float g[8] = {a.x, a.y, a.z, a.w, b.x, b.y, b.z, b.w};
          float u[8] = {c.x, c.y, c.z, c.w, d.x, d.y, d.z, d.w};
          epi.pair8(brow + ai * 128 + r, (bcol >> 1) + c8, g, u);
        }
      }
    }
  }
#undef SA
#undef SB
#undef STAGE_A
#undef STAGE_B
#undef LDA
#undef LDB
#undef MMA
#undef WAIT_V
#undef WAIT_L
#undef BAR
#undef SCHED
}

template <class AF, class EP>
__device__ __forceinline__ void gemm8_phase(char* smem, AF aptr, const u16* Bt, long ldb, int M, int N, int K, EP epi) {
  const int MT = M >> 8, NT = N >> 8;
  const int G = gridDim.x, per = G >> 3;
  const int vblk = ((G & 7) == 0) ? ((int)(blockIdx.x & 7) * per + (int)(blockIdx.x >> 3)) : (int)blockIdx.x;
  for (int t = vblk; t < MT * NT; t += G) {
    int nt = t % NT, mt = t / NT;
    gemm8_tile(smem, aptr, Bt, ldb, 0, K >> 6, mt * 256, nt * 256, epi);
    __syncthreads();
  }
}

#define EPI8 _Pragma("unroll") for (int ai = 0; ai < 2; ++ai) _Pragma("unroll") for (int bj = 0; bj < 2; ++bj) \
             _Pragma("unroll") for (int m = 0; m < 4; ++m) _Pragma("unroll") for (int n = 0; n < 2; ++n)
typedef f32x4 acc8_t[2][2][4][2];

struct Ep8Lat {
  u16* lat; float* gates; const float* rstd;
  __device__ __forceinline__ void operator()(acc8_t& acc, int rb, int cb, int col0) const {
    EPI8 {
      int col = cb + bj * 128 + n * 16;
#pragma unroll
      for (int j = 0; j < 4; ++j) {
        int row = rb + ai * 128 + m * 16 + j;
        float v = acc[ai][bj][m][n][j] * rstd[row];
        if (col < 1088) lat[(long)row * 1280 + col] = f2bf(v);
        else if (col < 1136) gates[(long)row * 48 + (col - 1088)] = sigmoidf_(v);
      }
    }
  }
};
struct Ep8Nsa {
  char* ws; const float* rstd;
  __device__ __forceinline__ void operator()(acc8_t& acc, int rb, int cb, int col0) const {
    u16* rm; int ld, cbase; bool tr = false; u16* tb = nullptr;
    if (col0 < 3072) { rm = (u16*)(ws + OFF_QN); ld = 3072; cbase = 0; }
    else if (col0 < 3840) { rm = (u16*)(ws + OFF_KC); ld = 768; cbase = 3072; }
    else if (col0 < 4352) { rm = (u16*)(ws + OFF_VC); ld = 512; cbase = 3840; }
    else if (col0 < 5120) { rm = (u16*)(ws + OFF_KS); ld = 768; cbase = 4352; }
    else if (col0 < 5632) { tr = true; tb = (u16*)(ws + OFF_VST); rm = nullptr; ld = 0; cbase = 5120; }
    else if (col0 < 6400) { rm = (u16*)(ws + OFF_KW); ld = 768; cbase = 5632; }
    else { tr = true; tb = (u16*)(ws + OFF_VWT); rm = nullptr; ld = 0; cbase = 6400; }
    EPI8 {
      int col = cb + bj * 128 + n * 16 - cbase;
      int row = rb + ai * 128 + m * 16;
      float v0 = acc[ai][bj][m][n][0] * rstd[row], v1 = acc[ai][bj][m][n][1] * rstd[row + 1];
      float v2 = acc[ai][bj][m][n][2] * rstd[row + 2], v3 = acc[ai][bj][m][n][3] * rstd[row + 3];
      if (tr) {
        int b = row >> 11, g = col >> 7, dv = col & 127;
        store_T4(tb + (long)(b * 4 + g) * 128 * 2048, 2048, dv, row, v0, v1, v2, v3);
      } else {
        rm[(long)row * ld + col] = f2bf(v0); rm[(long)(row + 1) * ld + col] = f2bf(v1);
        rm[(long)(row + 2) * ld + col] = f2bf(v2); rm[(long)(row + 3) * ld + col] = f2bf(v3);
      }
    }
  }
};
struct Ep8Gm {
  u16* gm; const float* rstd;
  __device__ __forceinline__ void operator()(acc8_t& acc, int rb, int cb, int col0) const {
    EPI8 {
#pragma unroll
      for (int j = 0; j < 4; ++j) {
        int row = rb + ai * 128 + m * 16 + j, col = cb + bj * 128 + n * 16;
        gm[(long)row * 4096 + col] = f2bf(sigmoidf_(acc[ai][bj][m][n][j] * rstd[row]));
      }
    }
  }
};
struct Ep8Q {
  u16* q; const float* rstd;
  __device__ __forceinline__ void operator()(acc8_t& acc, int rb, int cb, int col0) const {
    EPI8 {
#pragma unroll
      for (int j = 0; j < 4; ++j) {
        int row = rb + ai * 128 + m * 16 + j, col = cb + bj * 128 + n * 16;
        q[(long)row * 3072 + col] = f2bf(acc[ai][bj][m][n][j] * rstd[row]);
      }
    }
  }
};
struct Ep8KV {
  u16* km; u16* vtm; const float* rstd;
  __device__ __forceinline__ void operator()(acc8_t& acc, int rb, int cb, int col0) const {
    EPI8 {
      int col = cb + bj * 128 + n * 16;
      int row = rb + ai * 128 + m * 16;
      float v0 = acc[ai][bj][m][n][0] * rstd[row], v1 = acc[ai][bj][m][n][1] * rstd[row + 1];
      float v2 = acc[ai][bj][m][n][2] * rstd[row + 2], v3 = acc[ai][bj][m][n][3] * rstd[row + 3];
      if (col0 < 2048) {
        int h = col >> 7, d = col & 127;
        long o = (long)row * 3072 + h * 192 + d;
        km[o] = f2bf(v0); km[o + 3072] = f2bf(v1); km[o + 6144] = f2bf(v2); km[o + 9216] = f2bf(v3);
      } else {
        int c = col - 2048, h = c >> 7, dv = c & 127, b = row >> 11;
        store_T4(vtm + (long)(b * 16 + h) * 128 * 2048, 2048, dv, row, v0, v1, v2, v3);
      }
    }
  }
};
struct Ep8Cmp1 {
  u16* h; int ld; const float* bias;
  __device__ __forceinline__ void operator()(acc8_t& acc, int rb, int cb, int col0) const {
    EPI8 {
      int col = cb + bj * 128 + n * 16;
      float bv = bias[col];
#pragma unroll
      for (int j = 0; j < 4; ++j) {
        int row = rb + ai * 128 + m * 16 + j;
        h[(long)row * ld + col] = f2bf(gelu_tanh(acc[ai][bj][m][n][j] + bv));
      }
    }
  }
};
struct Ep8Part {
  float* part; int ld;
  __device__ __forceinline__ void operator()(acc8_t& acc, int rb, int cb, int col0) const {
    EPI8 {
#pragma unroll
      for (int j = 0; j < 4; ++j) {
        int row = rb + ai * 128 + m * 16 + j, col = cb + bj * 128 + n * 16;
        part[(long)row * ld + col] = acc[ai][bj][m][n][j];
      }
    }
  }
};
struct Ep8Cmp2K {
  float* kraw; const float* b2;
  __device__ __forceinline__ void operator()(acc8_t& acc, int rb, int cb, int col0) const {
    EPI8 {
      int col = cb + bj * 128 + n * 16;
      if (col < 192) {
        float bv = b2[col];
#pragma unroll
        for (int j = 0; j < 4; ++j) {
          int row = rb + ai * 128 + m * 16 + j;
          kraw[(long)row * 192 + col] = acc[ai][bj][m][n][j] + bv;
        }
      }
    }
  }
};
struct Ep8Cmp2V {
  static constexpr int kind = 2;
  u16* vct; const float* b2;
  __device__ __forceinline__ void operator()(acc8_t& acc, int rb, int cb, int col0) const {
    EPI8 {
      int dv = cb + bj * 128 + n * 16;
      if (dv < 128) {
        int row = rb + ai * 128 + m * 16;
        float bv = b2[dv];
        int bg = row >> 7, c = row & 127;
        uint2 o; o.x = pack2(acc[ai][bj][m][n][0] + bv, acc[ai][bj][m][n][1] + bv);
        o.y = pack2(acc[ai][bj][m][n][2] + bv, acc[ai][bj][m][n][3] + bv);
        *(uint2*)(vct + ((long)bg * 128 + dv) * 128 + vpos(c)) = o;
      }
    }
  }
};
template <int MODE>
struct Ep8Y {
  u16* mm; const u16* gm;
  __device__ __forceinline__ void operator()(acc8_t& acc, int rb, int cb, int col0) const {
    EPI8 {
#pragma unroll
      for (int j = 0; j < 4; ++j) {
        int row = rb + ai * 128 + m * 16 + j, col = cb + bj * 128 + n * 16;
        float v = bf2f(gm[(long)row * 4096 + MODE * 2048 + col]) * acc[ai][bj][m][n][j];
        if (MODE == 1) v += bf2f(mm[(long)row * 2048 + col]);
        mm[(long)row * 2048 + col] = f2bf(v);
      }
    }
  }
};
struct Ep8Out {
  float* out; const float* x;
  __device__ __forceinline__ void operator()(acc8_t& acc, int rb, int cb, int col0) const {
    EPI8 {
#pragma unroll
      for (int j = 0; j < 4; ++j) {
        long o = (long)(rb + ai * 128 + m * 16 + j) * 2048 + cb + bj * 128 + n * 16;
        out[o] = x[o] + acc[ai][bj][m][n][j];
      }
    }
  }
};
struct Ep8Ffn1 {
  u16* act; const float* rstd;
  __device__ __forceinline__ void operator()(acc8_t& acc, int rb, int cb, int col0) const {
#pragma unroll
    for (int ai = 0; ai < 2; ++ai)
#pragma unroll
      for (int m = 0; m < 4; ++m)
#pragma unroll
        for (int n = 0; n < 2; ++n)
#pragma unroll
          for (int j = 0; j < 4; ++j) {
            int row = rb + ai * 128 + m * 16 + j;
            int u = (col0 >> 8) * 128 + (cb - col0) + n * 16;
            float rs = rstd[row];
            float g = acc[ai][0][m][n][j] * rs, up = acc[ai][1][m][n][j] * rs;
            act[(long)row * 5632 + u] = f2bf(g * sigmoidf_(g) * up);
          }
  }
};
struct Ep8Ffn2 {
  float* out;
  __device__ __forceinline__ void operator()(acc8_t& acc, int rb, int cb, int col0) const {
    EPI8 {
#pragma unroll
      for (int j = 0; j < 4; ++j) {
        long o = (long)(rb + ai * 128 + m * 16 + j) * 2048 + cb + bj * 128 + n * 16;
        out[o] = out[o] + acc[ai][bj][m][n][j];
      }
    }
  }
};

__device__ __forceinline__ uint4 pack8(const float (&v)[8]) {
  uint4 o; o.x = pack2(v[0], v[1]); o.y = pack2(v[2], v[3]); o.z = pack2(v[4], v[5]); o.w = pack2(v[6], v[7]);
  return o;
}
__device__ __forceinline__ void unpack8(uint4 w, float (&v)[8]) {
  v[0] = bf2f((u16)(w.x & 0xffff)); v[1] = bf2f((u16)(w.x >> 16)); v[2] = bf2f((u16)(w.y & 0xffff)); v[3] = bf2f((u16)(w.y >> 16));
  v[4] = bf2f((u16)(w.z & 0xffff)); v[5] = bf2f((u16)(w.z >> 16)); v[6] = bf2f((u16)(w.w & 0xffff)); v[7] = bf2f((u16)(w.w >> 16));
}
struct R8Lat {
  static constexpr int kind = 0;
  u16* lat; float* gates; const float* rstd;
  __device__ __forceinline__ void row8(int row, int col, int col0, float (&v)[8]) const {
    float rs = rstd[row];
#pragma unroll
    for (int i = 0; i < 8; ++i) v[i] *= rs;
    if (col < 1088) *(uint4*)(lat + (long)row * 1280 + col) = pack8(v);
    else if (col < 1136) {
      float* gp = gates + (long)row * 48 + (col - 1088);
      *(float4*)gp = make_float4(sigmoidf_(v[0]), sigmoidf_(v[1]), sigmoidf_(v[2]), sigmoidf_(v[3]));
      *(float4*)(gp + 4) = make_float4(sigmoidf_(v[4]), sigmoidf_(v[5]), sigmoidf_(v[6]), sigmoidf_(v[7]));
    }
  }
};
struct R8NsaRM {
  static constexpr int kind = 0;
  char* ws; const float* rstd;
  __device__ __forceinline__ void row8(int row, int col, int col0, float (&v)[8]) const {
    u16* rm; int ld, cbase;
    if (col0 < 3072) { rm = (u16*)(ws + OFF_QN); ld = 3072; cbase = 0; }
    else if (col0 < 3840) { rm = (u16*)(ws + OFF_KC); ld = 768; cbase = 3072; }
    else if (col0 < 4352) { rm = (u16*)(ws + OFF_VC); ld = 512; cbase = 3840; }
    else if (col0 < 5120) { rm = (u16*)(ws + OFF_KS); ld = 768; cbase = 4352; }
    else { rm = (u16*)(ws + OFF_KW); ld = 768; cbase = 5120; }
    float rs = rstd[row];
#pragma unroll
    for (int i = 0; i < 8; ++i) v[i] *= rs;
    *(uint4*)(rm + (long)row * ld + (col - cbase)) = pack8(v);
  }
};
struct D8NsaT {
  static constexpr int kind = 2;
  char* ws; const float* rstd;
  __device__ __forceinline__ void operator()(acc8_t& acc, int rb, int cb, int col0) const {
    u16* tb = (u16*)(ws + (col0 < 512 ? OFF_VST : OFF_VWT));
    int cbase = col0 < 512 ? 0 : 512;
    EPI8 {
      int col = cb + bj * 128 + n * 16 - cbase;
      int row = rb + ai * 128 + m * 16;
      float v0 = acc[ai][bj][m][n][0] * rstd[row], v1 = acc[ai][bj][m][n][1] * rstd[row + 1];
      float v2 = acc[ai][bj][m][n][2] * rstd[row + 2], v3 = acc[ai][bj][m][n][3] * rstd[row + 3];
      int b = row >> 11, g = col >> 7, dv = col & 127;
      store_T4(tb + (long)(b * 4 + g) * 128 * 2048, 2048, dv, row, v0, v1, v2, v3);
    }
  }
};
struct R8Gm {
  static constexpr int kind = 0;
  u16* gm; const float* rstd;
  __device__ __forceinline__ void row8(int row, int col, int col0, float (&v)[8]) const {
    float rs = rstd[row];
#pragma unroll
    for (int i = 0; i < 8; ++i) v[i] = sigmoidf_(v[i] * rs);
    *(uint4*)(gm + (long)row * 4096 + col) = pack8(v);
  }
};
struct R8Q {
  static constexpr int kind = 0;
  u16* q; const float* rstd;
  __device__ __forceinline__ void row8(int row, int col, int col0, float (&v)[8]) const {
    float rs = rstd[row];
#pragma unroll
    for (int i = 0; i < 8; ++i) v[i] *= rs;
    *(uint4*)(q + (long)row * 3072 + col) = pack8(v);
  }
};
__device__ __forceinline__ void ld4(const u16* p, float* v);
struct R8K {
  static constexpr int kind = 0;
  char* ws; const float* g;
  __device__ __forceinline__ void row8(int row, int col, int col0, float (&v)[8]) const {
    u16* km = (u16*)(ws + OFF_KM); const float* rstd = (const float*)(ws + OFF_RSTD_CKV);
    const u16* lat = (const u16*)(ws + OFF_LAT);
    const float* cosm = (const float*)(ws + OFF_COSM); const float* sinm = (const float*)(ws + OFF_SINM);
    const int hl = (threadIdx.x & 15);
    const int h = col >> 7;
    const float rsk = rstd[row];
#pragma unroll
    for (int i = 0; i < 8; ++i) v[i] *= rsk;
    float kr[4];
    ld4(lat + (long)row * 1280 + 1024 + hl * 4, kr);
    float ss = 0.f;
#pragma unroll
    for (int i = 0; i < 8; ++i) ss += v[i] * v[i];
#pragma unroll
    for (int e = 0; e < 4; ++e) ss += kr[e] * kr[e];
    ss += __shfl_xor(ss, 1); ss += __shfl_xor(ss, 2); ss += __shfl_xor(ss, 4); ss += __shfl_xor(ss, 8);
    const float rs = rsqrtf(ss * (1.f / 192.f) + 1e-6f);
    const float4 ga = *(const float4*)(g + hl * 8), gb = *(const float4*)(g + hl * 8 + 4);
    v[0] *= rs * ga.x; v[1] *= rs * ga.y; v[2] *= rs * ga.z; v[3] *= rs * ga.w;
    v[4] *= rs * gb.x; v[5] *= rs * gb.y; v[6] *= rs * gb.z; v[7] *= rs * gb.w;
    u16* kp = km + (long)row * 3072 + h * 192;
    *(uint4*)(kp + hl * 8) = pack8(v);
    const float4 gr = *(const float4*)(g + 128 + hl * 4);
    float y[4] = {kr[0] * rs * gr.x, kr[1] * rs * gr.y, kr[2] * rs * gr.z, kr[3] * rs * gr.w};
    const int t = row & 2047, i0 = (hl & 7) * 4;
    const float4 cc = *(const float4*)(cosm + t * 32 + i0), sn = *(const float4*)(sinm + t * 32 + i0);
    float pz[4];
#pragma unroll
    for (int e = 0; e < 4; ++e) pz[e] = __shfl_xor(y[e], 8);
    const float sg = (hl < 8) ? -1.f : 1.f;
    float o0 = y[0] * cc.x + sg * pz[0] * sn.x, o1 = y[1] * cc.y + sg * pz[1] * sn.y;
    float o2 = y[2] * cc.z + sg * pz[2] * sn.z, o3 = y[3] * cc.w + sg * pz[3] * sn.w;
    uint2 o; o.x = pack2(o0, o1); o.y = pack2(o2, o3);
    *(uint2*)(kp + 128 + hl * 4) = o;
  }
};
struct D8V {
  static constexpr int kind = 2;
  u16* vtm; const float* rstd;
  __device__ __forceinline__ void operator()(acc8_t& acc, int rb, int cb, int col0) const {
    EPI8 {
      int c = cb + bj * 128 + n * 16;
      int row = rb + ai * 128 + m * 16;
      float v0 = acc[ai][bj][m][n][0] * rstd[row], v1 = acc[ai][bj][m][n][1] * rstd[row + 1];
      float v2 = acc[ai][bj][m][n][2] * rstd[row + 2], v3 = acc[ai][bj][m][n][3] * rstd[row + 3];
      int h = c >> 7, dv = c & 127, b = row >> 11;
      store_T4(vtm + (long)(b * 16 + h) * 128 * 2048, 2048, dv, row, v0, v1, v2, v3);
    }
  }
};
struct R8Part {
  static constexpr int kind = 0;
  float* part; int ld;
  __device__ __forceinline__ void row8(int row, int col, int col0, float (&v)[8]) const {
    float* pp = part + (long)row * ld + col;
    *(float4*)pp = make_float4(v[0], v[1], v[2], v[3]);
    *(float4*)(pp + 4) = make_float4(v[4], v[5], v[6], v[7]);
  }
};
struct R8Cmp2K {
  static constexpr int kind = 0;
  float* kraw; const float* b2;
  __device__ __forceinline__ void row8(int row, int col, int col0, float (&v)[8]) const {
    if (col < 192) {
      float* pp = kraw + (long)row * 192 + col;
      *(float4*)pp = make_float4(v[0] + b2[col], v[1] + b2[col + 1], v[2] + b2[col + 2], v[3] + b2[col + 3]);
      *(float4*)(pp + 4) = make_float4(v[4] + b2[col + 4], v[5] + b2[col + 5], v[6] + b2[col + 6], v[7] + b2[col + 7]);
    }
  }
};
template <int MODE>
struct R8Y {
  static constexpr int kind = 0;
  u16* mm; const u16* gm;
  __device__ __forceinline__ void row8(int row, int col, int col0, float (&v)[8]) const {
    float g[8];
    unpack8(*(const uint4*)(gm + (long)row * 4096 + MODE * 2048 + col), g);
#pragma unroll
    for (int i = 0; i < 8; ++i) v[i] *= g[i];
    if (MODE == 1) {
      float o[8];
      unpack8(*(const uint4*)(mm + (long)row * 2048 + col), o);
#pragma unroll
      for (int i = 0; i < 8; ++i) v[i] += o[i];
    }
    *(uint4*)(mm + (long)row * 2048 + col) = pack8(v);
  }
};
struct R8Out {
  static constexpr int kind = 0;
  u16* hb; const float* x; float* sspart;
  __device__ __forceinline__ void row8(int row, int col, int col0, float (&v)[8]) const {
    long o = (long)row * 2048 + col;
    float4 a = ld_nt4(x + o), b = ld_nt4(x + o + 4);
    v[0] += a.x; v[1] += a.y; v[2] += a.z; v[3] += a.w; v[4] += b.x; v[5] += b.y; v[6] += b.z; v[7] += b.w;
    float ss = 0.f;
#pragma unroll
    for (int i = 0; i < 8; ++i) ss += v[i] * v[i];
    ss = half_sum(ss);
    if ((threadIdx.x & 31) == 0) sspart[row * 8 + (col0 >> 8)] = ss;
    *(uint4*)(hb + o) = pack8(v);
  }
};
struct R8Ffn1 {
  static constexpr int kind = 1;
  u16* act; const float* rstd;
  __device__ __forceinline__ void pair8(int row, int u0, float (&g)[8], float (&u)[8]) const {
    float rs = rstd[row];
    float o[8];
#pragma unroll
    for (int i = 0; i < 8; ++i) { float gg = g[i] * rs; o[i] = gg * sigmoidf_(gg) * (u[i] * rs); }
    *(uint4*)(act + (long)row * 5632 + u0) = pack8(o);
  }
};
struct R8Ffn2 {
  static constexpr int kind = 0;
  float* out; const u16* hb;
  __device__ __forceinline__ void row8(int row, int col, int col0, float (&v)[8]) const {
    long o = (long)row * 2048 + col;
    float h[8];
    unpack8(*(const uint4*)(hb + o), h);
    st_nt4(out + o, h[0] + v[0], h[1] + v[1], h[2] + v[2], h[3] + v[3]);
    st_nt4(out + o + 4, h[4] + v[4], h[5] + v[5], h[6] + v[6], h[7] + v[7]);
  }
};

__device__ __forceinline__ void phase_latnorm(const u16* __restrict__ lat, float* rcq, float* rckv) {
  const int lane = threadIdx.x & 63;
  const int wave = (blockIdx.x * 512 + threadIdx.x) >> 6, nw = gridDim.x * 8;
  for (int it = wave; it < NTOK * 2; it += nw) {
    int row = it >> 1, which = it & 1;
    uint4 v = *(const uint4*)(lat + (long)row * 1280 + which * 512 + lane * 8);
    unsigned w[4] = {v.x, v.y, v.z, v.w};
    float ss = 0.f;
#pragma unroll
    for (int i = 0; i < 4; ++i) {
      float a = bf2f((u16)(w[i] & 0xffff)), b = bf2f((u16)(w[i] >> 16));
      ss += a * a + b * b;
    }
    ss = wave_sum(ss);
    if (lane == 0) (which ? rckv : rcq)[row] = rsqrtf(ss * (1.f / 512.f) + 1e-6f);
  }
}

template <int KIND>
__device__ __forceinline__ void norm_rope_vec(float (&v)[6], const float* __restrict__ g, const float* __restrict__ cosr,
                                              const float* __restrict__ sinr, int li) {
  float ss = 0.f;
#pragma unroll
  for (int i = 0; i < 6; ++i) ss += v[i] * v[i];
  ss = half_sum(ss);
  float rs = rsqrtf(ss * (1.f / 192.f) + 1e-6f);
  float4 g0 = *(const float4*)(g + 4 * li);
  float2 g1 = *(const float2*)(g + 128 + 2 * li);
  v[0] *= rs * g0.x; v[1] *= rs * g0.y; v[2] *= rs * g0.z; v[3] *= rs * g0.w;
  v[4] *= rs * g1.x; v[5] *= rs * g1.y;
  if (KIND == 0) {
    float p0 = __shfl_xor(v[4], 16), p1 = __shfl_xor(v[5], 16);
    int i0 = (2 * li) & 31;
    float c0 = cosr[i0], s0 = sinr[i0], c1 = cosr[i0 + 1], s1 = sinr[i0 + 1];
    if (li < 16) { v[4] = v[4] * c0 - p0 * s0; v[5] = v[5] * c1 - p1 * s1; }
    else { v[4] = v[4] * c0 + p0 * s0; v[5] = v[5] * c1 + p1 * s1; }
  } else {
    int lane = threadIdx.x & 63;
    int src = (li < 6) ? (lane + 6) : (lane - 6);
    src &= 63;
    float p[4];
#pragma unroll
    for (int e = 0; e < 4; ++e) p[e] = __shfl(v[e], src);
    if (li < 12) {
      int i0 = (li < 6) ? 4 * li : 4 * li - 24;
      float sg = (li < 6) ? -1.f : 1.f;
#pragma unroll
      for (int e = 0; e < 4; ++e) v[e] = v[e] * cosr[i0 + e] + sg * p[e] * sinr[i0 + e];
    }
  }
}
__device__ __forceinline__ void ld4(const u16* p, float* v) {
  uint2 w = *(const uint2*)p;
  v[0] = bf2f((u16)(w.x & 0xffff)); v[1] = bf2f((u16)(w.x >> 16));
  v[2] = bf2f((u16)(w.y & 0xffff)); v[3] = bf2f((u16)(w.y >> 16));
}
__device__ __forceinline__ void ld2(const u16* p, float& a, float& b) {
  unsigned w = *(const unsigned*)p; a = bf2f((u16)(w & 0xffff)); b = bf2f((u16)(w >> 16));
}
__device__ __forceinline__ void st6(u16* base, const float (&v)[6], int li) {
  uint2 o; o.x = pack2(v[0], v[1]); o.y = pack2(v[2], v[3]);
  *(uint2*)(base + 4 * li) = o;
  *(unsigned*)(base + 128 + 2 * li) = pack2(v[4], v[5]);
}

__device__ __forceinline__ void phase_mla_rope(const Params& p, bool probe = false) {
  char* ws = p.ws;
  u16* qm = (u16*)p.out;
  u16* km = (u16*)(ws + OFF_KM);
  const u16* lat = (const u16*)(ws + OFF_LAT);
  const float* cosm = (const float*)(ws + OFF_COSM); const float* sinm = (const float*)(ws + OFF_SINM);
  const int li = threadIdx.x & 31;
  const long hw = ((long)blockIdx.x * 512 + threadIdx.x) >> 5, nhw = (long)gridDim.x * 16;
  const long total = (long)NTOK * 16;
  for (long it0 = hw; it0 < total; it0 += 2 * nhw) {
    const bool hasB = it0 + nhw < total;
    const long itA = it0, itB = hasB ? it0 + nhw : it0;
    const int whA = 1, whB = 1;
    const long rowA = itA >> 4, rowB = itB >> 4;
    const int hA = (int)(itA & 15), hB = (int)(itB & 15);
    u16* baseA = (whA ? km : qm) + rowA * 3072 + hA * 192;
    u16* baseB = (whB ? km : qm) + rowB * 3072 + hB * 192;
    const u16* pA = whA ? (lat + rowA * 1280 + 1024 + 2 * li) : (const u16*)(baseA + 128 + 2 * li);
    const u16* pB = whB ? (lat + rowB * 1280 + 1024 + 2 * li) : (const u16*)(baseB + 128 + 2 * li);
    float vA[6], vB[6];
    ld4(baseA + 4 * li, vA); ld2(pA, vA[4], vA[5]);
    ld4(baseB + 4 * li, vB); ld2(pB, vB[4], vB[5]);
    const int tA = (int)(rowA & 2047), tB = (int)(rowB & 2047);
    norm_rope_vec<0>(vA, whA ? p.in[9] : p.in[8], cosm + tA * 32, sinm + tA * 32, li);
    norm_rope_vec<0>(vB, whB ? p.in[9] : p.in[8], cosm + tB * 32, sinm + tB * 32, li);
    if (probe) {
      u16* scr = (u16*)(ws + ACT + 264 * MIB);
      st6(scr + (rowA * 3072 + hA * 192), vA, li);
      if (hasB) st6(scr + (rowB * 3072 + hB * 192), vB, li);
    } else {
      st6(baseA, vA, li);
      if (hasB) st6(baseB, vB, li);
    }
  }
}

__device__ __forceinline__ void phase_nsa_rope(const Params& p, bool probe = false, int blk_first = 0) {
  char* ws = p.ws;
  u16* qn = (u16*)(ws + OFF_QN); u16* ks = (u16*)(ws + OFF_KS); u16* kw = (u16*)(ws + OFF_KW);
  const float* cosn = (const float*)(ws + OFF_COSN); const float* sinn = (const float*)(ws + OFF_SINN);
  const int li = threadIdx.x & 31;
  const long hw = ((long)((int)blockIdx.x - blk_first) * 512 + threadIdx.x) >> 5, nhw = (long)((int)gridDim.x - blk_first) * 16;
  const long total = (long)NTOK * 8;
  for (long it0 = hw; it0 < total; it0 += 2 * nhw) {
    float v[2][6]; u16* base[2]; int tq[2]; const float* gg[2];
#pragma unroll
    for (int u = 0; u < 2; ++u) {
      long it = it0 + u * nhw; if (it >= total) it = it0;
      long row = it >> 3; int s = (int)(it & 7);
      tq[u] = (int)(row & 2047);
      if (s < 4) { base[u] = ks + row * 768 + s * 192; gg[u] = p.in[11] + 192; }
      else { base[u] = kw + row * 768 + (s - 4) * 192; gg[u] = p.in[11] + 384; }
      ld4(base[u] + 4 * li, v[u]);
      ld2(base[u] + 128 + 2 * li, v[u][4], v[u][5]);
    }
#pragma unroll
    for (int u = 0; u < 2; ++u) norm_rope_vec<1>(v[u], gg[u], cosn + tq[u] * 24, sinn + tq[u] * 24, li);
#pragma unroll
    for (int u = 0; u < 2; ++u) if (u == 0 || it0 + nhw < total) {
      if (probe) st6((u16*)(ws + OFF_HB) + (base[u] - (u16*)(ws + OFF_QN)) % (32 * 1024 * 1024), v[u], li);
      else st6(base[u], v[u], li);
    }
  }
}

__device__ __forceinline__ void bias1_reduce(const Params& p) {
  char* ws = p.ws;
  const float* part = (const float*)(ws + OFF_BPART);
  float* bias1 = (float*)(ws + OFF_BIAS1);
  const int lane = threadIdx.x & 63;
  const int wave = (blockIdx.x * 512 + threadIdx.x) >> 6, nw = gridDim.x * 8;
  for (int n = wave; n < 1280; n += nw) {
    float sacc = part[lane * 1280 + n] + part[(lane + 64) * 1280 + n];
    sacc = wave_sum(sacc);
    if (lane == 0) bias1[n] = sacc + ((n < 768) ? p.in[15][n] : p.in[19][n - 768]);
  }
}

__device__ __forceinline__ void phase_cmp_norm(const Params& p) {
  char* ws = p.ws;
  const float* kraw = (const float*)(ws + OFF_KCRAW);
  u16* kcn = (u16*)(ws + OFF_KCN);
  const float* cosn = (const float*)(ws + OFF_COSN); const float* sinn = (const float*)(ws + OFF_SINN);
  const int li = threadIdx.x & 31;
  const long hw = ((long)blockIdx.x * 512 + threadIdx.x) >> 5, nhw = (long)gridDim.x * 16;
  for (long row = hw; row < 4096; row += nhw) {
    int c = (int)(row & 127);
    int pos = 16 * c + 31; if (pos > 2047) pos = 2047;
    const float* src = kraw + row * 192;
    float v[6];
    float4 a = *(const float4*)(src + 4 * li); float2 b2 = *(const float2*)(src + 128 + 2 * li);
    v[0] = a.x; v[1] = a.y; v[2] = a.z; v[3] = a.w; v[4] = b2.x; v[5] = b2.y;
    norm_rope_vec<1>(v, p.in[11], cosn + pos * 24, sinn + pos * 24, li);
    if (c == 127) { v[0] = v[1] = v[2] = v[3] = v[4] = v[5] = 0.f; }
    st6(kcn + row * 192, v, li);
  }
}

#define ATT_STAGE 40960
#define ATT_VOFF 24576
#define ATT_IMP 81920
#define ATT_IMPE 114688
#define ATT_SCORE 147456
#define ATT_MASK 155648

__device__ __forceinline__ void attn_S1(const char* Ks, int k2, const bf16x8 (&Q)[12], f32x16& S, int l31, int hh) {
#pragma unroll
  for (int r = 0; r < 16; ++r) S[r] = 0.f;
#pragma unroll
  for (int ks = 0; ks < 12; ++ks) {
    int r = k2 * 32 + l31, c = ks * 2 + hh;
    bf16x8 a = *(const bf16x8*)(Ks + r * 384 + (((c & ~7) | ((c & 7) ^ ((r >> 1) & 7))) << 4));
    S = __builtin_amdgcn_mfma_f32_32x32x16_bf16(a, Q[ks], S, 0, 0, 0);
  }
}

typedef __attribute__((ext_vector_type(4))) unsigned u32x4;
__device__ __forceinline__ float sm_prep(const bool MASKED, f32x16& S, int k2, f32x16 (&O)[4], float& m, float& l, int key0,
                                         int lo, int hi, float sc, int hh) {
  if (MASKED) {
#pragma unroll
    for (int r = 0; r < 16; ++r) {
      int key = key0 + k2 * 32 + (r & 3) + 8 * (r >> 2) + 4 * hh;
      S[r] = (key >= lo && key <= hi) ? S[r] : -1e30f;
    }
  }
  float mx = fmaxf(fmaxf(fmaxf(S[0], S[1]), fmaxf(S[2], S[3])), fmaxf(fmaxf(S[4], S[5]), fmaxf(S[6], S[7])));
  float mx2 = fmaxf(fmaxf(fmaxf(S[8], S[9]), fmaxf(S[10], S[11])), fmaxf(fmaxf(S[12], S[13]), fmaxf(S[14], S[15])));
  mx = fmaxf(mx, mx2);
  {
    const unsigned u = __float_as_uint(mx);
    auto sw = __builtin_amdgcn_permlane32_swap(u, u, false, false);
    mx = fmaxf(__uint_as_float(sw[0]), __uint_as_float(sw[1]));
  }
  if (!__all((mx - m) * sc <= 11.5416f)) {
    const float mnew = fmaxf(m, mx);
    float alpha = __builtin_amdgcn_exp2f((m - mnew) * sc);
    l *= alpha;
#pragma unroll
    for (int d = 0; d < 4; ++d)
#pragma unroll
      for (int r = 0; r < 16; ++r) O[d][r] *= alpha;
    m = mnew;
  }
  return (m > -1e29f) ? m * sc : 0.f;
}
typedef __attribute__((ext_vector_type(4))) unsigned u32x4;
__device__ __forceinline__ void sm_exp(const f32x16& S, float ms, float sc, u32x4 (&Pw)[2], float& l) {
  float psum = 0.f;
#pragma unroll
  for (int r = 0; r < 16; r += 2) {
    float p0 = __builtin_amdgcn_exp2f(fmaf(S[r], sc, -ms));
    float p1 = __builtin_amdgcn_exp2f(fmaf(S[r + 1], sc, -ms));
    psum += p0 + p1;
    Pw[r >> 3][(r & 7) >> 1] = pack2(p0, p1);
  }
  l += psum;
}
__device__ __forceinline__ void sm_pv(const u32x4 (&Pw)[2], const char* Vs, int k2, f32x16 (&O)[4], int l31, int hh) {
#pragma unroll
  for (int s2 = 0; s2 < 2; ++s2) {
    bf16x8 Pf = __builtin_bit_cast(bf16x8, Pw[s2]);
#pragma unroll
    for (int d = 0; d < 4; ++d) {
      int r = d * 32 + l31, c = (k2 * 2 + s2) * 2 + hh;
      bf16x8 a = *(const bf16x8*)(Vs + r * 128 + ((c ^ ((r >> 1) & 7)) << 4));
      O[d] = __builtin_amdgcn_mfma_f32_32x32x16_bf16(a, Pf, O[d], 0, 0, 0);
    }
  }
}
__device__ __forceinline__ void s_chain(const char* Ks, int k2, const bf16x8 (&Q)[12], f32x16& S, int l31, int hh) {
  const int r = k2 * 32 + l31;
  const char* rowp = Ks + r * 384;
  const int sw = (r >> 1) & 7;
#pragma unroll
  for (int ks = 0; ks < 12; ++ks) {
    const int c = ks * 2 + hh;
    bf16x8 a = *(const bf16x8*)(rowp + (((c & ~7) | ((c & 7) ^ sw)) << 4));
    S = __builtin_amdgcn_mfma_f32_32x32x16_bf16(a, Q[ks], S, 0, 0, 0);
  }
}

__device__ __forceinline__ void flash_step(const char* Ks, const char* Vs, const bf16x8 (&Q)[12], f32x16 (&O)[4], float& m,
                                           float& l, int key0, int lo, int hi, float sc, int l31, int hh) {
  const bool masked = !__all(lo <= key0 && hi >= key0 + 63);
  f32x16 S0, S1;
#pragma unroll
  for (int r = 0; r < 16; ++r) { S0[r] = 0.f; S1[r] = 0.f; }
  u32x4 P0[2], P1[2];
  s_chain(Ks, 0, Q, S0, l31, hh);
  const float ms0 = sm_prep(masked, S0, 0, O, m, l, key0, lo, hi, sc, hh);
  s_chain(Ks, 1, Q, S1, l31, hh);
  sm_exp(S0, ms0, sc, P0, l);
#pragma unroll
  for (int i = 0; i < 12; ++i) {
    __builtin_amdgcn_sched_group_barrier(0x100, 1, 0);
    __builtin_amdgcn_sched_group_barrier(0x008, 1, 0);
    __builtin_amdgcn_sched_group_barrier(0x002, 5, 0);
  }
  sm_pv(P0, Vs, 0, O, l31, hh);
  const float ms1 = sm_prep(masked, S1, 1, O, m, l, key0, lo, hi, sc, hh);
  sm_exp(S1, ms1, sc, P1, l);
  sm_pv(P1, Vs, 1, O, l31, hh);
}

template <class NextFn, class RangeFn>
__device__ __forceinline__ void flash_run(char* smem, const u16* __restrict__ Kb, long ldk, const u16* __restrict__ Vb,
                                          long ldv, int ntiles, int kt_first, NextFn next, RangeFn range,
                                          const bf16x8 (&Q)[12], f32x16 (&O)[4], float& m, float& l, float sc) {
  int tid = threadIdx.x;
  asm volatile("" : "+v"(tid));
  const int lane = tid & 63, l31 = lane & 31, hh = lane >> 5;
  unsigned kg0, kg1, kg2, vg0, vg1;
  {
    int id, r, c;
    id = tid;        r = id / 24; c = id - r * 24; c = (c & ~7) | ((c & 7) ^ ((r >> 1) & 7)); kg0 = (unsigned)(r * (int)ldk + c * 8) * 2u;
    id = tid + 512;  r = id / 24; c = id - r * 24; c = (c & ~7) | ((c & 7) ^ ((r >> 1) & 7)); kg1 = (unsigned)(r * (int)ldk + c * 8) * 2u;
    id = tid + 1024; r = id / 24; c = id - r * 24; c = (c & ~7) | ((c & 7) ^ ((r >> 1) & 7)); kg2 = (unsigned)(r * (int)ldk + c * 8) * 2u;
    r = tid >> 3; c = (tid & 7) ^ ((r >> 1) & 7); vg0 = (unsigned)(r * (int)ldv + c * 8) * 2u;
    r = (tid >> 3) + 64; c = (tid & 7) ^ ((r >> 1) & 7); vg1 = (unsigned)(r * (int)ldv + c * 8) * 2u;
  }
  const int sb = tid * 16;
#define FISSUE(kt, stg) do { \
    const char* kp_ = uniform_ptr((const char*)(Kb + (long)(kt) * 64 * ldk)); \
    const char* vp_ = uniform_ptr((const char*)(Vb + (kt) * 64)); \
    char* d_ = smem + (stg) * ATT_STAGE + sb; \
    __builtin_amdgcn_global_load_lds((const unsigned*)(kp_ + kg0), (unsigned*)(d_), 16, 0, 0); \
    __builtin_amdgcn_global_load_lds((const unsigned*)(kp_ + kg1), (unsigned*)(d_ + 8192), 16, 0, 0); \
    __builtin_amdgcn_global_load_lds((const unsigned*)(kp_ + kg2), (unsigned*)(d_ + 16384), 16, 0, 0); \
    __builtin_amdgcn_global_load_lds((const unsigned*)(vp_ + vg0), (unsigned*)(d_ + ATT_VOFF), 16, 0, 0); \
    __builtin_amdgcn_global_load_lds((const unsigned*)(vp_ + vg1), (unsigned*)(d_ + ATT_VOFF + 8192), 16, 0, 0); } while (0)
  asm volatile("s_waitcnt vmcnt(0)" ::: "memory");
  int k0 = kt_first, k1 = kt_first;
  FISSUE(k0, 0);
  if (ntiles > 1) { k1 = next(k0); FISSUE(k1, 1); }
  int st = 0;
  for (int it = 0; it < ntiles; ++it) {
    if (it + 1 < ntiles) asm volatile("s_waitcnt vmcnt(5)" ::: "memory");
    else asm volatile("s_waitcnt vmcnt(0)" ::: "memory");
    __builtin_amdgcn_s_barrier();
    __builtin_amdgcn_sched_barrier(0);
    int k2 = k1;
    if (it + 2 < ntiles) {
      k2 = next(k1);
      int st2 = st + 2; if (st2 >= 3) st2 -= 3;
      FISSUE(k2, st2);
    }
    int lo, hi;
    range(k0, lo, hi);
    int key0 = k0 * 64;
    int a = lo > key0 ? lo : key0, b = hi < key0 + 63 ? hi : key0 + 63;
    if (__any(a <= b)) {
      const char* Ks = smem + st * ATT_STAGE;
      flash_step(Ks, Ks + ATT_VOFF, Q, O, m, l, key0, lo, hi, sc, l31, hh);
    }
    k0 = k1; k1 = k2;
    st = (st == 2) ? 0 : st + 1;
  }
  __syncthreads();
#undef FISSUE
}

template <int KIND>
__device__ __forceinline__ void q_norm_rope(bf16x8 (&Q)[12], const float* __restrict__ g, const float* __restrict__ cosr,
                                            const float* __restrict__ sinr, int hh) {
  {
    int z = 0;
    asm volatile("" : "+v"(z));
    g += z;
  }
  float ss = 0.f;
#pragma unroll
  for (int ks = 0; ks < 12; ++ks) {
    float v[8];
    unpack8(__builtin_bit_cast(uint4, Q[ks]), v);
#pragma unroll
    for (int j = 0; j < 8; ++j) ss += v[j] * v[j];
  }
  ss += __shfl_xor(ss, 32);
  const float rs = rsqrtf(ss * (1.f / 192.f) + 1e-6f);
#pragma unroll
  for (int ks = 0; ks < 12; ++ks) asm volatile("" : "+v"(Q[ks]));
  constexpr int R0 = (KIND == 0) ? 8 : 0, R1 = (KIND == 0) ? 12 : 3;
#pragma unroll
  for (int ks = 0; ks < 12; ++ks) {
    if (ks >= R0 && ks < R1) continue;
    float v[8];
    unpack8(__builtin_bit_cast(uint4, Q[ks]), v);
    const float4 ga = *(const float4*)(g + ks * 16 + hh * 8), gb = *(const float4*)(g + ks * 16 + hh * 8 + 4);
    v[0] *= rs * ga.x; v[1] *= rs * ga.y; v[2] *= rs * ga.z; v[3] *= rs * ga.w;
    v[4] *= rs * gb.x; v[5] *= rs * gb.y; v[6] *= rs * gb.z; v[7] *= rs * gb.w;
    Q[ks] = __builtin_bit_cast(bf16x8, pack8(v));
  }
  if (KIND == 0) {
#pragma unroll
    for (int a = 0; a < 2; ++a) {
      float y1[8], y2[8];
      unpack8(__builtin_bit_cast(uint4, Q[8 + a]), y1);
      unpack8(__builtin_bit_cast(uint4, Q[10 + a]), y2);
#pragma unroll
      for (int j = 0; j < 8; ++j) {
        y1[j] *= rs * g[(8 + a) * 16 + hh * 8 + j];
        y2[j] *= rs * g[(10 + a) * 16 + hh * 8 + j];
      }
#pragma unroll
      for (int j = 0; j < 8; ++j) {
        int i = a * 16 + hh * 8 + j;
        float c = cosr[i], sn = sinr[i];
        float o1 = y1[j] * c - y2[j] * sn, o2 = y2[j] * c + y1[j] * sn;
        y1[j] = o1; y2[j] = o2;
      }
      Q[8 + a] = __builtin_bit_cast(bf16x8, pack8(y1));
      Q[10 + a] = __builtin_bit_cast(bf16x8, pack8(y2));
    }
  } else {
    float y[3][8], pr[3][8];
#pragma unroll
    for (int k = 0; k < 3; ++k) {
      unpack8(__builtin_bit_cast(uint4, Q[k]), y[k]);
#pragma unroll
      for (int j = 0; j < 8; ++j) y[k][j] *= rs * g[k * 16 + hh * 8 + j];
    }
#pragma unroll
    for (int k = 0; k < 3; ++k)
#pragma unroll
      for (int j = 0; j < 8; ++j) pr[k][j] = __shfl_xor(y[k][j], 32);
#pragma unroll
    for (int k = 0; k < 3; ++k) {
      float o[8];
#pragma unroll
      for (int j = 0; j < 8; ++j) {
        float pv, sg; int ib;
        if (k == 0) { pv = hh ? pr[2][j] : pr[1][j]; sg = -1.f; ib = hh ? 8 : 0; }
        else if (k == 1) { pv = hh ? pr[0][j] : pr[2][j]; sg = hh ? 1.f : -1.f; ib = hh ? 0 : 16; }
        else { pv = hh ? pr[1][j] : pr[0][j]; sg = 1.f; ib = hh ? 16 : 8; }
        int i = ib + j;
        o[j] = y[k][j] * cosr[i] + sg * pv * sinr[i];
      }
      Q[k] = __builtin_bit_cast(bf16x8, pack8(o));
    }
  }
}

__device__ __forceinline__ void pack_o_carry(const f32x16 (&O)[4], float scale, uint4 (&carry)[8]) {
#pragma unroll
  for (int d = 0; d < 4; ++d)
#pragma unroll
    for (int k = 0; k < 2; ++k) {
      float v[8];
#pragma unroll
      for (int e = 0; e < 4; ++e) {
        auto sw = __builtin_amdgcn_permlane32_swap(__float_as_uint(O[d][(2 * k) * 4 + e] * scale),
                                                   __float_as_uint(O[d][(2 * k + 1) * 4 + e] * scale), false, false);
        v[e] = __uint_as_float(sw[0]); v[4 + e] = __uint_as_float(sw[1]);
      }
      carry[d * 2 + k] = pack8(v);
    }
}
__device__ __forceinline__ void add_o_carry(const f32x16 (&O)[4], float scale, uint4 (&carry)[8]) {
#pragma unroll
  for (int d = 0; d < 4; ++d)
#pragma unroll
    for (int k = 0; k < 2; ++k) {
      float v[8], o[8];
#pragma unroll
      for (int e = 0; e < 4; ++e) {
        auto sw = __builtin_amdgcn_permlane32_swap(__float_as_uint(O[d][(2 * k) * 4 + e] * scale),
                                                   __float_as_uint(O[d][(2 * k + 1) * 4 + e] * scale), false, false);
        v[e] = __uint_as_float(sw[0]); v[4 + e] = __uint_as_float(sw[1]);
      }
      unpack8(carry[d * 2 + k], o);
#pragma unroll
      for (int e = 0; e < 8; ++e) v[e] += o[e];
      carry[d * 2 + k] = pack8(v);
    }
}
__device__ __forceinline__ void store_o_carry(u16* op, const f32x16 (&O)[4], float scale, int hh, const uint4 (&carry)[8]) {
#pragma unroll
  for (int d = 0; d < 4; ++d)
#pragma unroll
    for (int k = 0; k < 2; ++k) {
      float v[8], o[8];
#pragma unroll
      for (int e = 0; e < 4; ++e) {
        auto sw = __builtin_amdgcn_permlane32_swap(__float_as_uint(O[d][(2 * k) * 4 + e] * scale),
                                                   __float_as_uint(O[d][(2 * k + 1) * 4 + e] * scale), false, false);
        v[e] = __uint_as_float(sw[0]); v[4 + e] = __uint_as_float(sw[1]);
      }
      unpack8(carry[d * 2 + k], o);
#pragma unroll
      for (int e = 0; e < 8; ++e) v[e] += o[e];
      *(uint4*)(op + d * 32 + 8 * (2 * k + hh)) = pack8(v);
    }
}
template <bool ACCUM>
__device__ __forceinline__ void store_o(u16* op, const f32x16 (&O)[4], float scale, int hh) {
#pragma unroll
  for (int d = 0; d < 4; ++d)
#pragma unroll
    for (int k = 0; k < 2; ++k) {
      float v[8];
#pragma unroll
      for (int e = 0; e < 4; ++e) {
        const unsigned xe = __float_as_uint(O[d][(2 * k) * 4 + e] * scale);
        const unsigned yo = __float_as_uint(O[d][(2 * k + 1) * 4 + e] * scale);
        auto sw = __builtin_amdgcn_permlane32_swap(xe, yo, false, false);
        v[e] = __uint_as_float(sw[0]);
        v[4 + e] = __uint_as_float(sw[1]);
      }
      const int dv = d * 32 + 8 * (2 * k + hh);
      if (ACCUM) {
        float o[8];
        unpack8(*(const uint4*)(op + dv), o);
#pragma unroll
        for (int e = 0; e < 8; ++e) v[e] += o[e];
      }
      *(uint4*)(op + dv) = pack8(v);
    }
}

__device__ __forceinline__ void phase_mla_attn(const Params& p, char* smem) {
  char* ws = p.ws;
  const u16* qm = (const u16*)p.out;
  const u16* km = (const u16*)(ws + OFF_KM);
  const u16* vtm = (const u16*)(ws + OFF_VTM);
  u16* o = (u16*)(ws + OFF_OMLA);
  const float sc = 0.07216878364870322f * LOG2E;
  const int G = gridDim.x, blk = blockIdx.x;
  for (int r = 0; r * G < 1024; ++r) {
    int idx = r * G + ((r & 1) ? (G - 1 - blk) : blk);
    if (idx >= 1024) continue;
    int tid_ = threadIdx.x;
    asm volatile("" : "+v"(tid_));
    const int lane = tid_ & 63, wid = tid_ >> 6, l31 = lane & 31, hh = lane >> 5;
    int qblk = 7 - (idx >> 7), bh = idx & 127;
    if (G == 256) {
      const int x = blk & 7, lid = blk >> 3, sl = lid & 7;
      bh = 16 * x + 4 * r + (lid >> 3);
      qblk = (r & 1) ? 7 - sl : sl;
    }
    const int b = bh >> 4, h = bh & 15;
    int t = qblk * 256 + wid * 32 + l31;
    const u16* qp = qm + ((long)(b * 2048 + t)) * 3072 + h * 192;
    bf16x8 Q[12];
#pragma unroll
    for (int ks = 0; ks < 12; ++ks) Q[ks] = *(const bf16x8*)(qp + ks * 16 + hh * 8);
    q_norm_rope<0>(Q, p.in[8], (const float*)(ws + OFF_COSM) + t * 32, (const float*)(ws + OFF_SINM) + t * 32, hh);
    f32x16 O[4];
#pragma unroll
    for (int d = 0; d < 4; ++d)
#pragma unroll
      for (int i = 0; i < 16; ++i) O[d][i] = 0.f;
    float m = -1e30f, l = 0.f;
    flash_run(smem, km + (long)b * 2048 * 3072 + h * 192, 3072, vtm + (long)(b * 16 + h) * 128 * 2048, 2048,
              (qblk + 1) * 4, 0, [](int kt) { return kt + 1; }, [&](int kt, int& lo, int& hi) { lo = 0; hi = t; }, Q, O, m, l, sc);
    float lt = l + __shfl_xor(l, 32);
    float inv = lt > 0.f ? 1.f / lt : 0.f;
    store_o<false>(o + (long)(b * 2048 + t) * 2048 + h * 128, O, inv, hh);
  }
}

__device__ __forceinline__ void phase_nsa_attn(const Params& p, char* smem) {
  char* ws = p.ws;
  const u16* qn = (const u16*)(ws + OFF_QN);
  const u16* kcn = (const u16*)(ws + OFF_KCN);
  const u16* vct = (const u16*)(ws + OFF_VCT);
  const u16* ksb = (const u16*)(ws + OFF_KS);
  const u16* vst = (const u16*)(ws + OFF_VST);
  const u16* kwb = (const u16*)(ws + OFF_KW);
  const u16* vwt = (const u16*)(ws + OFF_VWT);
  const float* gates = (const float*)(ws + OFF_GATES);
  u16* onsa = (u16*)(ws + OFF_ONSA);
  float* scoreArr = (float*)(smem + ATT_SCORE);
  unsigned* maskArr = (unsigned*)(smem + ATT_MASK);
  const float sc = 0.07216878364870322f * LOG2E;
  const int G = gridDim.x, blk = blockIdx.x;
  for (int r = 0; r * G < 1024; ++r) {
    int idx = r * G + ((r & 1) ? (G - 1 - blk) : blk);
    if (idx >= 1024) continue;
    int tid = threadIdx.x;
    asm volatile("" : "+v"(tid));
    const int lane = tid & 63, wid = tid >> 6, l31 = lane & 31, hh = lane >> 5;
    int tt = 31 - (idx >> 5), bg = idx & 31;
    if (G == 256) {
      const int x = blk & 7, lid = blk >> 3;
      bg = 4 * x + r;
      tt = (r & 1) ? 31 - lid : lid;
    }
    const int b = bg >> 2, g = bg & 3;
    const int hr = wid & 3, th = wid >> 2, h = g * 4 + hr;
    const int ql = th * 32 + l31, t = tt * 64 + ql;
    const long row = (long)b * 2048 + t;
    const u16* qp = qn + row * 3072 + h * 192;
    bf16x8 Q[12];
#pragma unroll
    for (int ks = 0; ks < 12; ++ks) Q[ks] = *(const bf16x8*)(qp + ks * 16 + hh * 8);
    q_norm_rope<1>(Q, p.in[10], (const float*)(ws + OFF_COSN) + t * 24, (const float*)(ws + OFF_SINN) + t * 24, hh);
    const float g0 = gates[row * 48 + h * 3], g1 = gates[row * 48 + h * 3 + 1], g2 = gates[row * 48 + h * 3 + 2];
    u16* op = onsa + row * 2048 + h * 128;
    f32x16 O[4];
    const int hic = (t >= 31) ? ((t - 31) >> 4) : -1;
    unsigned mq = 0;
    uint4 carry[8];
#pragma unroll
    for (int i = 0; i < 8; ++i) carry[i] = make_uint4(0u, 0u, 0u, 0u);
#pragma unroll 1
    for (int br = 0; br < 3; ++br) {
      const u16* Kb; const u16* Vb; int ldk, ldv; unsigned U; float gate;
      if (br == 0) {
        Kb = kcn + (long)bg * 128 * 192; Vb = vct + (long)bg * 128 * 128; ldk = 192; ldv = 128; U = 3u; gate = g0;
      } else if (br == 1) {
        Kb = ksb + (long)b * 2048 * 768 + g * 192; Vb = vst + (long)bg * 128 * 2048; ldk = 768; ldv = 2048; gate = g1;
        mq = maskArr[ql];
        U = 0;
#pragma unroll 4
        for (int i = 0; i < 64; ++i) U |= maskArr[i];
        U &= (tt == 31) ? 0xffffffffu : ((2u << tt) - 1u);
      } else {
        Kb = kwb + (long)b * 2048 * 768 + g * 192; Vb = vwt + (long)bg * 128 * 2048; ldk = 768; ldv = 2048; gate = g2;
        int kt0 = tt - 8 > 0 ? tt - 8 : 0;
        unsigned hiM = (tt == 31) ? 0xffffffffu : ((2u << tt) - 1u);
        U = hiM & ~((1u << kt0) - 1u);
      }
#pragma unroll
      for (int d = 0; d < 4; ++d)
#pragma unroll
        for (int i = 0; i < 16; ++i) O[d][i] = 0.f;
      float m = -1e30f, l = 0.f;
      flash_run(smem, Kb, ldk, Vb, ldv, __popc(U), __ffs(U) - 1,
                [&](int kt) { return __ffs(U & ~((2u << kt) - 1u)) - 1; },
                [&](int kt, int& lo, int& hi) {
                  if (br == 0) { lo = 0; hi = hic; }
                  else if (br == 1) { bool bit = (mq >> kt) & 1u; lo = bit ? 0 : 1; hi = bit ? t : 0; }
                  else { lo = t - 511; hi = t; }
                }, Q, O, m, l, sc);
      float lt = l + __shfl_xor(l, 32);
      float inv = lt > 0.f ? 1.f / lt : 0.f;
      if (br == 0) pack_o_carry(O, gate * inv, carry);
      else if (br == 1) add_o_carry(O, gate * inv, carry);
      else store_o_carry(op, O, gate * inv, hh, carry);
      if (br == 0) {
        float* arrO = (float*)(smem + ATT_IMP);
        float* arrE = (float*)(smem + ATT_IMPE);
#pragma unroll 1
        for (int q4 = 0; q4 < 4; ++q4) {
          const int tl = q4 >> 1, k2 = q4 & 1;
          f32x16 S;
          attn_S1(smem + tl * ATT_STAGE, k2, Q, S, l31, hh);
#pragma unroll
          for (int ii = 0; ii < 4; ++ii) {
            float pv[4];
#pragma unroll
            for (int e = 0; e < 4; ++e) {
              int c = q4 * 32 + 8 * ii + 4 * hh + e;
              pv[e] = (c <= hic) ? __builtin_amdgcn_exp2f((S[ii * 4 + e] - m) * sc) * inv : 0.f;
            }
            int j = (q4 * 4 + ii) * 2 + hh;
            arrO[(hr * 64 + ql) * 32 + j] = pv[0] + pv[1] + pv[2] + 0.5f * pv[3];
            arrE[(hr * 64 + ql) * 32 + j] = 0.5f * pv[3];
          }
        }
        __syncthreads();
#pragma unroll 1
        for (int ps = 0; ps < 4; ++ps) {
          int q = ps * 16 + (tid >> 5), j = tid & 31;
          float imp = 0.f;
#pragma unroll
          for (int hd = 0; hd < 4; ++hd) {
            imp += arrO[(hd * 64 + q) * 32 + j];
            if (j > 0) imp += arrE[(hd * 64 + q) * 32 + j - 1];
          }
          bool forced = (j == 0) || (j == tt) || (j == tt - 1);
          bool valid = j <= tt;
          scoreArr[q * 32 + j] = forced ? 1e9f : (valid ? imp : -1e9f);
        }
        __syncthreads();
#pragma unroll 1
        for (int ps = 0; ps < 4; ++ps) {
          int q = ps * 16 + (tid >> 5), j = tid & 31;
          float s = scoreArr[q * 32 + j];
          int cnt = 0;
#pragma unroll 4
          for (int j2 = 0; j2 < 32; ++j2) {
            float s2 = scoreArr[q * 32 + j2];
            cnt += (s2 > s || (s2 == s && j2 < j)) ? 1 : 0;
          }
          unsigned long long bal = __ballot(cnt < 16);
          unsigned mk = (lane < 32) ? (unsigned)bal : (unsigned)(bal >> 32);
          if (j == 0) maskArr[q] = mk;
        }
        __syncthreads();
      }
    }
  }
}

#define XB_TMO      128
#define XB_XCNT(j)  (256  + 64 * (j))
#define XB_XSUB(j)  (1280 + 64 * (j))
#define XB_XGEN(j)  (2304 + 64 * (j))
#define XB_TOP      3328
#define XB_TOPGEN   3392
#define XCD_BAR_WORDS 3456
#define XB_SPIN_CAP (1u << 18)
#define LAS __attribute__((address_space(3)))
__device__ __forceinline__ unsigned xb_ld(unsigned* p) { return __hip_atomic_load(p, __ATOMIC_RELAXED, __HIP_MEMORY_SCOPE_AGENT); }
__device__ __forceinline__ unsigned xb_add(unsigned* p, unsigned v) { return __hip_atomic_fetch_add(p, v, __ATOMIC_RELAXED, __HIP_MEMORY_SCOPE_AGENT); }
__device__ __forceinline__ unsigned xb_xcc_id() { return (unsigned)__builtin_amdgcn_s_getreg((3 << 11) | 20) & 0xFu; }
#define XB_SPIN(cond, bar) do { unsigned _sp = 0; while (cond) { __builtin_amdgcn_s_sleep(1); \
    if ((++_sp & 255u) == 0u) { if (xb_ld(&(bar)[XB_TMO])) break; if (_sp > XB_SPIN_CAP) { atomicAdd(&(bar)[XB_TMO], 1u); break; } } } } while (0)
struct XcdBarrier { unsigned* bar; unsigned x; volatile LAS unsigned* st; };
__device__ __forceinline__ XcdBarrier xcd_barrier_post(unsigned* bar, volatile LAS unsigned* st) {
  XcdBarrier b; b.bar = bar; b.x = xb_xcc_id(); b.st = st;
  if (threadIdx.x == 0) (void)xb_add(&bar[XB_XCNT(b.x)], 1u);
  return b;
}
__device__ __forceinline__ void xcd_barrier_complete(unsigned* bar, unsigned x, unsigned& nloc, unsigned& nx) {
  const unsigned G = gridDim.x * gridDim.y * gridDim.z;
  unsigned sum, cnt, mine, sp = 0u;
  for (;;) {
    sum = 0u; cnt = 0u; mine = 0u;
#pragma unroll
    for (unsigned j = 0; j < 16; ++j) { const unsigned c = xb_ld(&bar[XB_XCNT(j)]); sum += c; cnt += (c > 0u) ? 1u : 0u; mine = (j == x) ? c : mine; }
    if (sum == G) break;
    __builtin_amdgcn_s_sleep(1);
    if ((++sp & 255u) == 0u) { if (xb_ld(&bar[XB_TMO])) break; if (sp > XB_SPIN_CAP) { atomicAdd(&bar[XB_TMO], 1u); break; } }
  }
  nloc = mine > 0u ? mine : 1u; nx = cnt > 0u ? cnt : 1u;
}
__device__ __forceinline__ void xcd_barrier(const XcdBarrier& b) {
  asm volatile("s_waitcnt vmcnt(0)" ::: "memory");
  __syncthreads();
  if (threadIdx.x == 0) {
    unsigned* bar = b.bar;
    __builtin_amdgcn_s_waitcnt(0);
    unsigned nloc = b.st[0], nx = b.st[1];
    if (nloc == 0u) { xcd_barrier_complete(bar, b.x, nloc, nx); b.st[0] = nloc; b.st[1] = nx; }
    const unsigned old = xb_add(&bar[XB_XSUB(b.x)], 1u);
    const unsigned gen = old / nloc;
    if (old + 1u == (gen + 1u) * nloc) {
      __builtin_amdgcn_fence(__ATOMIC_RELEASE, "agent");
      asm volatile("s_waitcnt vmcnt(0)" ::: "memory");
      const unsigned og = xb_add(&bar[XB_TOP], 1u);
      const unsigned tg = og / nx;
      if (og + 1u == (tg + 1u) * nx) xb_add(&bar[XB_TOPGEN], 1u);
      else XB_SPIN(xb_ld(&bar[XB_TOPGEN]) == tg, bar);
      __builtin_amdgcn_fence(__ATOMIC_ACQUIRE, "agent");
      xb_add(&bar[XB_XGEN(b.x)], 1u);
      asm volatile("s_waitcnt vmcnt(0)" ::: "memory");
    } else {
      XB_SPIN(xb_ld(&bar[XB_XGEN(b.x)]) == gen, bar);
      __builtin_amdgcn_fence(__ATOMIC_ACQUIRE, "agent");
      asm volatile("s_waitcnt vmcnt(0)" ::: "memory");
    }
  }
  __syncthreads();
}

#ifndef TESTPHASE
#define TESTPHASE -1
#endif
#ifndef PROBE_ATT
#define PROBE_ATT 0
#endif
#ifndef PROBE_DBL
#define PROBE_DBL 0
#endif
#if PROBE_DBL
#define PHASE(n) for (int rep_ = 0; rep_ <= ((PROBE_DBL >> (n)) & 1); ++rep_) if ((TESTPHASE < 0 || TESTPHASE == (n)) && p.phase_lo <= (n) && (n) < p.phase_hi)
#else
#define PHASE(n) if ((TESTPHASE < 0 || TESTPHASE == (n)) && p.phase_lo <= (n) && (n) < p.phase_hi)
#endif
#define PHASE_UNUSED(n) if ((TESTPHASE < 0 || TESTPHASE == (n)) && p.phase_lo <= (n) && (n) < p.phase_hi)
#define SYNC(n) if (p.phase_lo <= (n) && (n) + 1 < p.phase_hi) { xcd_barrier(xb); }

__global__ void __launch_bounds__(512) mega(Params p) {
  cg::grid_group grid = cg::this_grid();
  extern __shared__ __attribute__((aligned(16))) char smem[];
  __shared__ uint4 xb_words;
  char* ws = p.ws;
  if (threadIdx.x == 0) xb_words = make_uint4(0u, 0u, 0u, 0u);
  __syncthreads();
  const XcdBarrier xb = xcd_barrier_post((unsigned*)(ws + OFF_BAR), (volatile LAS unsigned*)&xb_words);
  const float* rstd_x = (const float*)(ws + OFF_RSTD_X);
  if (p.phase_hi > 1000) grid.sync();
  PHASE(0) phase_prep(p, smem);
#if PROBE_ATT & 4
  PHASE(0) phase_prep(p, smem);
#endif
  SYNC(0)
  PHASE(1) gemm8_phase(smem, ARow{(const u16*)(ws + OFF_XB), 2048}, (const u16*)(ws + OFF_WT_IN), 2048, NTOK, 1280, 2048,
                      R8Lat{(u16*)(ws + OFF_LAT), (float*)(ws + OFF_GATES), rstd_x});
  PHASE(1) {
    const int G = gridDim.x;
    int sidx = -1, scnt = 0;
    if (G == 256) { const int x = blockIdx.x & 7; if (x >= 2) { sidx = (x - 2) * 32 + (int)(blockIdx.x >> 3); scnt = 192; } else { sidx = -2; } }
    if (sidx != -2) {
      transpose_convert<0>(smem, p.in[14], 768, 6144, 0, 768, (u16*)(ws + OFF_WT_CK1), 6144, 0, nullptr, sidx, scnt);
      transpose_convert<0>(smem, p.in[18], 512, 4096, 0, 512, (u16*)(ws + OFF_WT_CV1), 4096, 0, nullptr, sidx, scnt);
      transpose_convert<0>(smem, p.in[22], 2048, 2048, 0, 2048, (u16*)(ws + OFF_WT_PM), 2048, 0, nullptr, sidx, scnt);
      transpose_convert<0>(smem, p.in[23], 2048, 2048, 0, 2048, (u16*)(ws + OFF_WT_PN), 2048, 0, nullptr, sidx, scnt);
      transpose_convert<0>(smem, p.in[24], 2048, 2048, 0, 2048, (u16*)(ws + OFF_WT_O), 2048, 0, nullptr, sidx, scnt);
    }
  }
  SYNC(1)
  PHASE(2) phase_latnorm((const u16*)(ws + OFF_LAT), (float*)(ws + OFF_RSTD_CQ), (float*)(ws + OFF_RSTD_CKV));
  SYNC(2)
  PHASE(3) {
    gemm8_phase(smem, ARow{(const u16*)(ws + OFF_LAT), 1280}, (const u16*)(ws + OFF_WT_UQ), 512, NTOK, 3072, 512,
               R8Q{(u16*)p.out, (const float*)(ws + OFF_RSTD_CQ)});
    gemm8_phase(smem, ARow{(const u16*)(ws + OFF_LAT) + 512, 1280}, (const u16*)(ws + OFF_WT_UKV), 512, NTOK, 2048, 512,
               R8K{ws, p.in[9]});
    gemm8_phase(smem, ARow{(const u16*)(ws + OFF_LAT) + 512, 1280}, (const u16*)(ws + OFF_WT_UKV) + (long)2048 * 512, 512, NTOK,
               2048, 512, D8V{(u16*)(ws + OFF_VTM), (const float*)(ws + OFF_RSTD_CKV)});
  }
  SYNC(3)
  PHASE(5) {
    if ((threadIdx.x >> 6) >= 4) __builtin_amdgcn_s_setprio(1);
    phase_mla_attn(p, smem);
    __builtin_amdgcn_s_setprio(0);
  }
#if PROBE_ATT & 1
  PHASE(5) phase_mla_attn(p, smem);
#endif
  SYNC(5)
  PHASE(6) {
    gemm8_phase(smem, ARow{(const u16*)(ws + OFF_XB), 2048}, (const u16*)(ws + OFF_WT_IN) + (long)1280 * 2048, 2048, NTOK,
               5888, 2048, R8NsaRM{ws, rstd_x});
    gemm8_phase(smem, ARow{(const u16*)(ws + OFF_XB), 2048}, (const u16*)(ws + OFF_WT_IN) + (long)7168 * 2048, 2048, NTOK,
               1024, 2048, D8NsaT{ws, rstd_x});
    gemm8_phase(smem, ARow{(const u16*)(ws + OFF_XB), 2048}, (const u16*)(ws + OFF_WT_IN) + (long)8192 * 2048, 2048, NTOK,
               4096, 2048, R8Gm{(u16*)p.out, rstd_x});
  }
  SYNC(6)
  PHASE(8) {
    bias1_reduce(p);
    for (int it = blockIdx.x; it < 256; it += gridDim.x) {
      int isV, tile, sp, mt, nt_, nkt, ld, kd;
      if (it < 192) { isV = 0; tile = it >> 2; sp = it & 3; mt = tile / 3; nt_ = tile - mt * 3; nkt = 24; ld = 768; kd = 6144; }
      else { int i2 = it - 192; isV = 1; tile = i2 >> 1; sp = i2 & 1; mt = tile >> 1; nt_ = tile & 1; nkt = 32; ld = 512; kd = 4096; }
      R8Part ep{(float*)(ws + (isV ? OFF_PARTV : OFF_PARTK)) + (long)sp * 4096 * ld, ld};
      ACmpU af{(const u16*)(ws + (isV ? OFF_VC : OFF_KC)), ld, isV ? 128 : 192, isV};
      gemm8_tile(smem, af, (const u16*)(ws + (isV ? OFF_WT_CV1 : OFF_WT_CK1)), kd, sp * nkt, nkt, mt * 256, nt_ * 256, ep);
      __syncthreads();
    }
  }
  SYNC(8)
  PHASE(9) {
    {
      const float* pk = (const float*)(ws + OFF_PARTK); const float* pv = (const float*)(ws + OFF_PARTV);
      const float* bias1 = (const float*)(ws + OFF_BIAS1);
      u16* hk = (u16*)(ws + OFF_HK); u16* hv = (u16*)(ws + OFF_HV);
      long tid = (long)blockIdx.x * 512 + threadIdx.x, nth = (long)gridDim.x * 512;
      for (long i = tid; i < (long)4096 * 768 / 4; i += nth) {
        long e = i * 4; int col = (int)(e % 768);
        float4 a = *(const float4*)(pk + e), b2 = *(const float4*)(pk + 4096L * 768 + e);
        float4 c = *(const float4*)(pk + 2 * 4096L * 768 + e), d = *(const float4*)(pk + 3 * 4096L * 768 + e);
        float4 bb = *(const float4*)(bias1 + col);
        uint2 o;
        o.x = pack2(gelu_tanh(((a.x + b2.x) + (c.x + d.x)) + bb.x), gelu_tanh(((a.y + b2.y) + (c.y + d.y)) + bb.y));
        o.y = pack2(gelu_tanh(((a.z + b2.z) + (c.z + d.z)) + bb.z), gelu_tanh(((a.w + b2.w) + (c.w + d.w)) + bb.w));
        *(uint2*)(hk + e) = o;
      }
      for (long i = tid; i < (long)4096 * 512 / 4; i += nth) {
        long e = i * 4; int col = (int)(e % 512);
        float4 a = *(const float4*)(pv + e), b2 = *(const float4*)(pv + 4096L * 512 + e);
        float4 bb = *(const float4*)(bias1 + 768 + col);
        uint2 o;
        o.x = pack2(gelu_tanh((a.x + b2.x) + bb.x), gelu_tanh((a.y + b2.y) + bb.y));
        o.y = pack2(gelu_tanh((a.z + b2.z) + bb.z), gelu_tanh((a.w + b2.w) + bb.w));
        *(uint2*)(hv + e) = o;
      }
    }
    xcd_barrier(xb);
    {
      const int G = gridDim.x, blk = blockIdx.x;
      const int rope_first = (G > 32) ? 32 : 0;
      for (int t = blk; t < 16; t += G) {
        R8Cmp2K ek{(float*)(ws + OFF_KCRAW), p.in[17]};
        gemm8_tile(smem, ARow{(const u16*)(ws + OFF_HK), 768}, (const u16*)(ws + OFF_WT_CK2), 768, 0, 12, t * 256, 0, ek);
        __syncthreads();
      }
      for (int t = blk - 16; t < 16; t += G) {
        if (t < 0) continue;
        Ep8Cmp2V ev{(u16*)(ws + OFF_VCT), p.in[21]};
        gemm8_tile(smem, ARow{(const u16*)(ws + OFF_HV), 512}, (const u16*)(ws + OFF_WT_CV2), 512, 0, 8, t * 256, 0, ev);
        __syncthreads();
      }
      if (blk >= rope_first) phase_nsa_rope(p, false, rope_first);
    }
  }
  SYNC(9)
  PHASE(10) phase_cmp_norm(p);
  SYNC(10)
  PHASE(11) {
    if ((threadIdx.x >> 6) >= 4) __builtin_amdgcn_s_setprio(1);
    phase_nsa_attn(p, smem);
    __builtin_amdgcn_s_setprio(0);
  }
#if PROBE_ATT & 2
  PHASE(11) phase_nsa_attn(p, smem);
#endif
  SYNC(11)
  PHASE(12) {
    gemm8_phase(smem, ARow{(const u16*)(ws + OFF_OMLA), 2048}, (const u16*)(ws + OFF_WT_PM), 2048, NTOK, 2048, 2048,
               R8Y<0>{(u16*)(ws + OFF_M), (const u16*)p.out});
    gemm8_phase(smem, ARow{(const u16*)(ws + OFF_ONSA), 2048}, (const u16*)(ws + OFF_WT_PN), 2048, NTOK, 2048, 2048,
               R8Y<1>{(u16*)(ws + OFF_M), (const u16*)p.out});
  }
  SYNC(12)
  PHASE(13) gemm8_phase(smem, ARow{(const u16*)(ws + OFF_M), 2048}, (const u16*)(ws + OFF_WT_O), 2048, NTOK, 2048, 2048,
                       R8Out{(u16*)(ws + OFF_HB), p.in[0], (float*)(ws + OFF_SSPART)});
  SYNC(13)
  PHASE(14) {
    {
      const float* sp = (const float*)(ws + OFF_SSPART); float* rh = (float*)(ws + OFF_RSTD_H);
      for (int row = blockIdx.x * 512 + threadIdx.x; row < NTOK; row += gridDim.x * 512) {
        float4 a = *(const float4*)(sp + row * 8), b = *(const float4*)(sp + row * 8 + 4);
        float ss = ((a.x + a.y) + (a.z + a.w)) + ((b.x + b.y) + (b.z + b.w));
        rh[row] = rsqrtf(ss * (1.f / 2048.f) + 1e-6f);
      }
    }
    transpose_convert<1>(smem, p.in[26], 5632, 2048, 0, 5632, (u16*)(ws + OFF_WT_GU), 2048, 0, p.in[25]);
    transpose_convert<2>(smem, p.in[27], 5632, 2048, 0, 5632, (u16*)(ws + OFF_WT_GU), 2048, 0, p.in[25]);
    transpose_convert<0>(smem, p.in[28], 2048, 5632, 0, 2048, (u16*)(ws + OFF_WT_D), 5632, 0, nullptr);
  }
  SYNC(14)
  PHASE(15) gemm8_phase(smem, ARow{(const u16*)(ws + OFF_HB), 2048}, (const u16*)(ws + OFF_WT_GU), 2048, NTOK, 11264, 2048,
                       R8Ffn1{(u16*)(ws + OFF_ACTF), (const float*)(ws + OFF_RSTD_H)});
  SYNC(15)
#if PROBE_ATT & 128
  for (int i_ = 0; i_ < 20; ++i_) xcd_barrier(xb);
#endif
  PHASE(16) gemm8_phase(smem, ARow{(const u16*)(ws + OFF_ACTF), 5632}, (const u16*)(ws + OFF_WT_D), 5632, NTOK, 2048, 5632,
                       R8Ffn2{p.out, (const u16*)(ws + OFF_HB)});
}

extern "C" void kernel_launch(void* const* d_in, const int* in_sizes, int n_in, void* d_out, int out_size, void* d_ws,
                              size_t ws_size, hipStream_t stream) {
  constexpr size_t kDynLds = 159744;
  static int grid_blocks = 0;
  if (!grid_blocks) {
    int dev = 0, cus = 0, per_cu = 0;
    (void)hipGetDevice(&dev);
    (void)hipDeviceGetAttribute(&cus, hipDeviceAttributeMultiprocessorCount, dev);
    (void)hipFuncSetAttribute((const void*)mega, hipFuncAttributeMaxDynamicSharedMemorySize, (int)kDynLds);
    (void)hipOccupancyMaxActiveBlocksPerMultiprocessor(&per_cu, mega, 512, kDynLds);
    if (per_cu < 1) per_cu = 1;
    if (per_cu > 1) per_cu = 1;
    grid_blocks = cus * per_cu;
  }
  Params p{};
  for (int i = 0; i < 29; ++i) p.in[i] = (const float*)d_in[i];
  p.out = (float*)d_out;
  p.ws = (char*)d_ws;
  p.phase_lo = 0;
  p.phase_hi = 17;
  (void)hipMemsetAsync((char*)d_ws + OFF_BAR, 0, XCD_BAR_WORDS * sizeof(unsigned), stream);
  void* args[] = {&p};
  hipError_t e = hipLaunchCooperativeKernel((void*)mega, dim3(grid_blocks), dim3(512), args, kDynLds, stream);
  if (e != hipSuccess) fprintf(stderr, "cooperative launch failed: %s (grid %d)\n", hipGetErrorString(e), grid_blocks);
}
```

```cpp
#include <hip/hip_runtime.h>
#include <hip/hip_bf16.h>
#include <hip/hip_cooperative_groups.h>
#include <cstdio>
namespace cg = cooperative_groups;

typedef __attribute__((ext_vector_type(8))) short bf16x8;
typedef __attribute__((ext_vector_type(16))) float f32x16;
typedef unsigned short u16;

#define NTOK 16384
#define SEQ 2048
#define LOG2E 1.4426950408889634f
#define MIB (1ull << 20)

#ifndef DEBUG_CHECKS
#define DEBUG_CHECKS 0
#endif

#define OFF_RSTD_X   (0)
#define OFF_RSTD_CQ  (65536)
#define OFF_RSTD_CKV (131072)
#define OFF_RSTD_H   (196608)
#define OFF_COSM     (262144)
#define OFF_SINM     (524288)
#define OFF_COSN     (786432)
#define OFF_SINN     (983040)
#define OFF_BPART    (5 * MIB)
#define OFF_BIAS1    (1179648)
#define OFF_DIAG     (1184768)
#define OFF_SSPART   (6 * MIB)
#define OFF_BAR      (7 * MIB)
#define OFF_GATES    (2 * MIB)
#define OFF_WT_IN    (8 * MIB)
#define OFF_WT_UQ    (56 * MIB)
#define OFF_WT_UKV   (59 * MIB)
#define OFF_WT_CK1   (63 * MIB)
#define OFF_WT_CV1   (72 * MIB)
#define OFF_WT_CK2   (76 * MIB)
#define OFF_WT_CV2   (76 * MIB + 512 * 1024)
#define OFF_WT_PM    (77 * MIB)
#define OFF_WT_PN    (85 * MIB)
#define OFF_WT_O     (93 * MIB)
#define ACT          (101 * MIB)
#define OFF_XB       (ACT + 0 * MIB)
#define OFF_LAT      (ACT + 64 * MIB)
#define OFF_KM       (ACT + 104 * MIB)
#define OFF_VTM      (ACT + 200 * MIB)
#define OFF_OMLA     (ACT + 264 * MIB)
#define OFF_QN       (ACT + 64 * MIB)
#define OFF_KC       (ACT + 160 * MIB)
#define OFF_KS       (ACT + 184 * MIB)
#define OFF_KW       (ACT + 208 * MIB)
#define OFF_VC       (ACT + 232 * MIB)
#define OFF_VST      (ACT + 248 * MIB)
#define OFF_VWT      (ACT + 328 * MIB)
#define OFF_HK       (ACT + 344 * MIB)
#define OFF_HV       (ACT + 350 * MIB)
#define OFF_KCRAW    (ACT + 354 * MIB)
#define OFF_VCT      (ACT + 357 * MIB)
#define OFF_KCN      (ACT + 358 * MIB)
#define OFF_PARTK    (ACT + 0 * MIB)
#define OFF_PARTV    (ACT + 48 * MIB)
#define OFF_ONSA     (ACT + 0 * MIB)
#define OFF_M        (ACT + 64 * MIB)
#define OFF_HB       (ACT + 344 * MIB)
#define OFF_WT_GU    (ACT + 264 * MIB)
#define OFF_WT_D     (ACT + 308 * MIB)
#define OFF_ACTF     (ACT + 0 * MIB)

struct Params {
  const float* in[29];
  float* out;
  char* ws;
  int phase_lo, phase_hi;
};

__device__ __forceinline__ u16 f2bf(float f) {
  unsigned u = __float_as_uint(f);
  u += 0x7fffu + ((u >> 16) & 1u);
  return (u16)(u >> 16);
}
__device__ __forceinline__ float bf2f(u16 b) { return __uint_as_float(((unsigned)b) << 16); }
typedef __bf16 bf16x2_t __attribute__((ext_vector_type(2)));
typedef float float2_t __attribute__((ext_vector_type(2)));
__device__ __forceinline__ unsigned pack2(float a, float b) {
  float2_t f = {a, b};
  bf16x2_t h = __builtin_convertvector(f, bf16x2_t);
  return __builtin_bit_cast(unsigned, h);
}
__device__ __forceinline__ float sigmoidf_(float x) {
  return __builtin_amdgcn_rcpf(1.f + __builtin_amdgcn_exp2f(-1.4426950408889634f * x));
}
__device__ __forceinline__ float wave_sum(float v) {
  v += __shfl_xor(v, 32); v += __shfl_xor(v, 16); v += __shfl_xor(v, 8);
  v += __shfl_xor(v, 4); v += __shfl_xor(v, 2); v += __shfl_xor(v, 1);
  return v;
}
__device__ __forceinline__ float half_sum(float v) {
  v += __shfl_xor(v, 16); v += __shfl_xor(v, 8);
  v += __shfl_xor(v, 4); v += __shfl_xor(v, 2); v += __shfl_xor(v, 1);
  return v;
}
typedef float f4_t __attribute__((ext_vector_type(4)));
__device__ __forceinline__ float4 ld_nt4(const float* p) {
  f4_t v = __builtin_nontemporal_load((const f4_t*)p);
  return make_float4(v.x, v.y, v.z, v.w);
}
__device__ __forceinline__ void st_nt4(float* p, float a, float b, float c, float d) {
  f4_t v = {a, b, c, d};
  __builtin_nontemporal_store(v, (f4_t*)p);
}
__device__ __forceinline__ int vpos(int t) {
  return (t & ~15) | (((t >> 2) & 1) << 3) | (((t >> 3) & 1) << 2) | (t & 3);
}

__device__ __forceinline__ void rows_to_bf16(const float* __restrict__ x, u16* __restrict__ xb, float* __restrict__ rstd) {
  const int lane = threadIdx.x & 63;
  const int wave = (blockIdx.x * 512 + threadIdx.x) >> 6, nw = gridDim.x * 8;
  for (int row = wave; row < NTOK; row += nw) {
    const float4* src = (const float4*)(x + (long)row * 2048);
    uint2* dst = (uint2*)(xb + (long)row * 2048);
    float ss = 0.f;
#pragma unroll
    for (int i = 0; i < 8; ++i) {
      float4 v = ld_nt4((const float*)(src + lane + i * 64));
      ss += v.x * v.x + v.y * v.y + v.z * v.z + v.w * v.w;
      uint2 o; o.x = pack2(v.x, v.y); o.y = pack2(v.z, v.w);
      dst[lane + i * 64] = o;
    }
    ss = wave_sum(ss);
    if (lane == 0) rstd[row] = rsqrtf(ss * (1.f / 2048.f) + 1e-6f);
  }
}

template <int MODE>
__device__ __forceinline__ void transpose_convert(char* smem, const float* __restrict__ src, int ldsrc, int K, int col0, int ncols,
                                  u16* __restrict__ dst, long ldd, int dst_row0, const float* __restrict__ gain,
                                  int bidx = -1, int bcnt = 0) {
  float* tile = (float*)smem;
  const int tid = threadIdx.x;
  const int ntn = (ncols + 255) >> 8, ntk = K >> 6;
  if (bidx < 0) { bidx = blockIdx.x; bcnt = gridDim.x; }
  for (int t = bidx; t < ntn * ntk; t += bcnt) {
    const int tn = t % ntn, tk = t / ntn;
    const int k0 = tk * 64, n0 = tn * 256;
    const int c4 = (tid & 63) * 4;
    float4 v[8];
#pragma unroll
    for (int i = 0; i < 8; ++i) {
      int kk = (tid >> 6) + i * 8;
      v[i] = make_float4(0.f, 0.f, 0.f, 0.f);
      if (n0 + c4 < ncols) v[i] = ld_nt4(src + (long)(k0 + kk) * ldsrc + col0 + n0 + c4);
    }
#pragma unroll
    for (int i = 0; i < 8; ++i) {
      int kk = (tid >> 6) + i * 8;
      float gv = gain ? gain[k0 + kk] : 1.f;
      tile[kk * 257 + c4] = v[i].x * gv; tile[kk * 257 + c4 + 1] = v[i].y * gv;
      tile[kk * 257 + c4 + 2] = v[i].z * gv; tile[kk * 257 + c4 + 3] = v[i].w * gv;
    }
    __syncthreads();
    {
      int nn = tid >> 1, kh = (tid & 1) * 32;
      if (n0 + nn < ncols) {
        int n = n0 + nn;
        int drow = (MODE == 0) ? (dst_row0 + n) : ((n >> 7) * 256 + (n & 127) + (MODE == 2 ? 128 : 0));
        u16* dp = dst + (long)drow * ldd + k0 + kh;
#pragma unroll
        for (int q = 0; q < 4; ++q) {
          uint4 o;
          o.x = pack2(tile[(kh + q * 8 + 0) * 257 + nn], tile[(kh + q * 8 + 1) * 257 + nn]);
          o.y = pack2(tile[(kh + q * 8 + 2) * 257 + nn], tile[(kh + q * 8 + 3) * 257 + nn]);
          o.z = pack2(tile[(kh + q * 8 + 4) * 257 + nn], tile[(kh + q * 8 + 5) * 257 + nn]);
          o.w = pack2(tile[(kh + q * 8 + 6) * 257 + nn], tile[(kh + q * 8 + 7) * 257 + nn]);
          *(uint4*)(dp + q * 8) = o;
        }
      }
    }
    __syncthreads();
  }
}

__device__ __forceinline__ void zero_fill16(char* p, long bytes) {
  long n = bytes >> 4;
  long tid = (long)blockIdx.x * 512 + threadIdx.x, nth = (long)gridDim.x * 512;
  uint4 z = make_uint4(0, 0, 0, 0);
  for (long i = tid; i < n; i += nth) ((uint4*)p)[i] = z;
}

__device__ __forceinline__ void phase_prep(const Params& p, char* smem) {
  char* ws = p.ws;
  rows_to_bf16(p.in[0], (u16*)(ws + OFF_XB), (float*)(ws + OFF_RSTD_X));
  u16* wtin = (u16*)(ws + OFF_WT_IN);
  const float* w_in = p.in[2];
  transpose_convert<0>(smem, w_in, 12144, 2048, 0, 1088, wtin, 2048, 0, p.in[1]);
  transpose_convert<0>(smem, w_in, 12144, 2048, 8000, 48, wtin, 2048, 1088, p.in[1]);
  zero_fill16((char*)(wtin + (long)1136 * 2048), (long)144 * 2048 * 2);
  transpose_convert<0>(smem, w_in, 12144, 2048, 1088, 5120, wtin, 2048, 1280, p.in[1]);
  transpose_convert<0>(smem, w_in, 12144, 2048, 6720, 768, wtin, 2048, 6400, p.in[1]);
  transpose_convert<0>(smem, w_in, 12144, 2048, 6208, 512, wtin, 2048, 7168, p.in[1]);
  transpose_convert<0>(smem, w_in, 12144, 2048, 7488, 512, wtin, 2048, 7680, p.in[1]);
  transpose_convert<0>(smem, w_in, 12144, 2048, 8048, 4096, wtin, 2048, 8192, p.in[1]);
  transpose_convert<0>(smem, p.in[5], 3072, 512, 0, 3072, (u16*)(ws + OFF_WT_UQ), 512, 0, p.in[3]);
  transpose_convert<0>(smem, p.in[6], 2048, 512, 0, 2048, (u16*)(ws + OFF_WT_UKV), 512, 0, p.in[4]);
  transpose_convert<0>(smem, p.in[7], 2048, 512, 0, 2048, (u16*)(ws + OFF_WT_UKV), 512, 2048, p.in[4]);
  transpose_convert<0>(smem, p.in[16], 192, 768, 0, 192, (u16*)(ws + OFF_WT_CK2), 768, 0, nullptr);
  zero_fill16(ws + OFF_WT_CK2 + (long)192 * 768 * 2, (long)64 * 768 * 2);
  transpose_convert<0>(smem, p.in[20], 128, 512, 0, 128, (u16*)(ws + OFF_WT_CV2), 512, 0, nullptr);
  zero_fill16(ws + OFF_WT_CV2 + (long)128 * 512 * 2, (long)128 * 512 * 2);
  {
    float* cosm = (float*)(ws + OFF_COSM); float* sinm = (float*)(ws + OFF_SINM);
    float* cosn = (float*)(ws + OFF_COSN); float* sinn = (float*)(ws + OFF_SINN);
    long tid = (long)blockIdx.x * 512 + threadIdx.x, nth = (long)gridDim.x * 512;
    for (long i = tid; i < 2048 * 32; i += nth) {
      int t = (int)(i >> 5), k = (int)(i & 31);
      double inv = exp2(-(double)k / 32.0 * 18.931568569324174);
      double a = (double)t * inv;
      cosm[i] = (float)cos(a); sinm[i] = (float)sin(a);
    }
    for (long i = tid; i < 2048 * 24; i += nth) {
      int t = (int)(i / 24), k = (int)(i % 24);
      double inv = exp2(-(double)k / 24.0 * 18.931568569324174);
      double a = (double)t * inv;
      cosn[i] = (float)cos(a); sinn[i] = (float)sin(a);
    }
  }
  {
    float* part = (float*)(ws + OFF_BPART);
    for (int job = blockIdx.x; job < 256; job += gridDim.x) {
      int which = job >> 7, kc = job & 127;
      int Kd = which ? 4096 : 6144, N = which ? 512 : 768;
      const float* pe = which ? p.in[13] : p.in[12];
      const float* w1 = which ? p.in[18] : p.in[14];
      int klen = Kd / 128;
      for (int n = threadIdx.x; n < N; n += 512) {
        float s = 0.f;
#pragma unroll 8
        for (int k = kc * klen; k < (kc + 1) * klen; ++k) s += pe[k] * w1[(long)k * N + n];
        part[kc * 1280 + which * 768 + n] = s;
      }
    }
  }
}

template <class AF, class EP>
__device__ __forceinline__ void gemm_tile(char* smem, AF aptr, const u16* __restrict__ Bt, long ldb, int K, int row0,
                                          int col0, EP& epi) {
  const int tid = threadIdx.x, lane = tid & 63, wid = tid >> 6;
  const int wm = wid >> 1, wn = wid & 1, l31 = lane & 31, hh = lane >> 5;
  f32x16 acc[2][2];
#pragma unroll
  for (int i = 0; i < 2; ++i)
#pragma unroll
    for (int j = 0; j < 2; ++j)
#pragma unroll
      for (int r = 0; r < 16; ++r) acc[i][j][r] = 0.f;
  uint4 ra[4], rb[2];
  const int nk = K >> 6;
  const int sr = tid >> 3, sc = tid & 7;
  const int swz = (sc ^ ((sr >> 1) & 7)) << 4;
  auto gload = [&](int kt) {
#pragma unroll
    for (int i = 0; i < 4; ++i) ra[i] = *(const uint4*)(aptr(row0 + sr + i * 64, kt * 64 + sc * 8));
#pragma unroll
    for (int i = 0; i < 2; ++i) rb[i] = *(const uint4*)(Bt + (long)(col0 + sr + i * 64) * ldb + kt * 64 + sc * 8);
  };
  auto lstore = [&](int buf) {
    char* As = smem + buf * 49152;
    char* Bs = As + 32768;
#pragma unroll
    for (int i = 0; i < 4; ++i) *(uint4*)(As + (sr + i * 64) * 128 + swz) = ra[i];
#pragma unroll
    for (int i = 0; i < 2; ++i) *(uint4*)(Bs + (sr + i * 64) * 128 + swz) = rb[i];
  };
  gload(0);
  lstore(0);
  __syncthreads();
  for (int kt = 0; kt < nk; ++kt) {
    if (kt + 1 < nk) gload(kt + 1);
    const char* As = smem + (kt & 1) * 49152;
    const char* Bs = As + 32768;
#pragma unroll
    for (int ks = 0; ks < 4; ++ks) {
      bf16x8 a[2], b[2];
#pragma unroll
      for (int i = 0; i < 2; ++i) {
        int r = wm * 64 + i * 32 + l31, c = ks * 2 + hh;
        a[i] = *(const bf16x8*)(As + r * 128 + ((c ^ ((r >> 1) & 7)) << 4));
      }
#pragma unroll
      for (int j = 0; j < 2; ++j) {
        int r = wn * 64 + j * 32 + l31, c = ks * 2 + hh;
        b[j] = *(const bf16x8*)(Bs + r * 128 + ((c ^ ((r >> 1) & 7)) << 4));
      }
#pragma unroll
      for (int i = 0; i < 2; ++i)
#pragma unroll
        for (int j = 0; j < 2; ++j) acc[i][j] = __builtin_amdgcn_mfma_f32_32x32x16_bf16(a[i], b[j], acc[i][j], 0, 0, 0);
    }
    if (kt + 1 < nk) lstore((kt + 1) & 1);
    __syncthreads();
  }
  epi(acc, row0 + wm * 64 + 4 * hh, col0 + wn * 64 + l31, col0);
}

template <class AF, class EP>
__device__ __forceinline__ void gemm_phase(char* smem, AF aptr, const u16* Bt, long ldb, int M, int N, int K, EP epi) {
  const int MT = M >> 8, NT = N >> 7;
  for (int t = blockIdx.x; t < MT * NT; t += gridDim.x) {
    int nt = t % NT, mt = t / NT;
    gemm_tile(smem, aptr, Bt, ldb, K, mt * 256, nt * 128, epi);
  }
}

struct ARow {
  const u16* A; long lda;
  __device__ __forceinline__ const u16* operator()(int row, int k) const { return A + (long)row * lda + k; }
  __device__ __forceinline__ unsigned rowoff(int row) const { return (unsigned)(row * (int)lda); }
  __device__ __forceinline__ long koff(int kt) const { return (long)kt * 64; }
};
template <int DH, int LD>
struct ACmp {
  const u16* A;
  __device__ __forceinline__ const u16* operator()(int row, int k) const {
    int bg = row >> 7, c = row & 127, b = bg >> 2, g = bg & 3;
    int j = k / DH, d = k - j * DH;
    int tok = 16 * c + j; if (tok > 2047) tok = 2047;
    return A + ((long)(b * 2048 + tok)) * LD + g * DH + d;
  }
  __device__ __forceinline__ unsigned rowoff(int row) const {
    int bg = row >> 7, c = row & 127, b = bg >> 2, g = bg & 3;
    return (unsigned)((b * 2048 + 16 * c) * LD + g * DH);
  }
  __device__ __forceinline__ long koff(int kt) const {
    int k = kt * 64; int j = k / DH;
    return (long)j * LD + (k - j * DH);
  }
};

struct ACmpU {
  const u16* A; int LD, DH, isV;
  __device__ __forceinline__ unsigned rowoff(int row) const {
    int bg = row >> 7, c = row & 127, b = bg >> 2, g = bg & 3;
    return (unsigned)((b * 2048 + 16 * c) * LD + g * DH);
  }
  __device__ __forceinline__ long koff(int kt) const {
    int j = isV ? (kt >> 1) : ((kt * 43) >> 7);
    int rem = kt - j * (isV ? 2 : 3);
    return (long)j * LD + rem * 64;
  }
};
#define EPI_ITER for (int i = 0; i < 2; ++i) for (int j = 0; j < 2; ++j) for (int rg = 0; rg < 4; ++rg)

struct EpLat {
  u16* lat; float* gates; const float* rstd;
  __device__ __forceinline__ void operator()(f32x16 (&acc)[2][2], int rb, int cb, int col0) const {
#pragma unroll
    EPI_ITER {
      int col = cb + j * 32;
#pragma unroll
      for (int e = 0; e < 4; ++e) {
        int row = rb + i * 32 + 8 * rg + e;
        float v = acc[i][j][rg * 4 + e] * rstd[row];
        if (col < 1088) lat[(long)row * 1280 + col] = f2bf(v);
        else if (col < 1136) gates[(long)row * 48 + (col - 1088)] = sigmoidf_(v);
      }
    }
  }
};
__device__ __forceinline__ void store_T4(u16* base, long ld, int dv, int row, float v0, float v1, float v2, float v3) {
  int t = row & 2047;
  uint2 o; o.x = pack2(v0, v1); o.y = pack2(v2, v3);
  *(uint2*)(base + (long)dv * ld + vpos(t)) = o;
}
struct EpNsa {
  char* ws; const float* rstd;
  __device__ __forceinline__ void operator()(f32x16 (&acc)[2][2], int rb, int cb, int col0) const {
    u16* rm; int ld, cbase; bool tr = false; u16* tb = nullptr;
    if (col0 < 3072) { rm = (u16*)(ws + OFF_QN); ld = 3072; cbase = 0; }
    else if (col0 < 3840) { rm = (u16*)(ws + OFF_KC); ld = 768; cbase = 3072; }
    else if (col0 < 4352) { rm = (u16*)(ws + OFF_VC); ld = 512; cbase = 3840; }
    else if (col0 < 5120) { rm = (u16*)(ws + OFF_KS); ld = 768; cbase = 4352; }
    else if (col0 < 5632) { tr = true; tb = (u16*)(ws + OFF_VST); rm = nullptr; ld = 0; cbase = 5120; }
    else if (col0 < 6400) { rm = (u16*)(ws + OFF_KW); ld = 768; cbase = 5632; }
    else { tr = true; tb = (u16*)(ws + OFF_VWT); rm = nullptr; ld = 0; cbase = 6400; }
#pragma unroll
    EPI_ITER {
      int col = cb + j * 32 - cbase;
      int row = rb + i * 32 + 8 * rg;
      float v0 = acc[i][j][rg * 4 + 0] * rstd[row], v1 = acc[i][j][rg * 4 + 1] * rstd[row + 1];
      float v2 = acc[i][j][rg * 4 + 2] * rstd[row + 2], v3 = acc[i][j][rg * 4 + 3] * rstd[row + 3];
      if (tr) {
        int b = row >> 11, g = col >> 7, dv = col & 127;
        store_T4(tb + (long)(b * 4 + g) * 128 * 2048, 2048, dv, row, v0, v1, v2, v3);
      } else {
        rm[(long)row * ld + col] = f2bf(v0); rm[(long)(row + 1) * ld + col] = f2bf(v1);
        rm[(long)(row + 2) * ld + col] = f2bf(v2); rm[(long)(row + 3) * ld + col] = f2bf(v3);
      }
    }
  }
};
struct EpGm {
  u16* gm; const float* rstd;
  __device__ __forceinline__ void operator()(f32x16 (&acc)[2][2], int rb, int cb, int col0) const {
#pragma unroll
    EPI_ITER {
#pragma unroll
      for (int e = 0; e < 4; ++e) {
        int row = rb + i * 32 + 8 * rg + e, col = cb + j * 32;
        gm[(long)row * 4096 + col] = f2bf(sigmoidf_(acc[i][j][rg * 4 + e] * rstd[row]));
      }
    }
  }
};
struct EpQ {
  u16* q; const float* rstd;
  __device__ __forceinline__ void operator()(f32x16 (&acc)[2][2], int rb, int cb, int col0) const {
#pragma unroll
    EPI_ITER {
#pragma unroll
      for (int e = 0; e < 4; ++e) {
        int row = rb + i * 32 + 8 * rg + e, col = cb + j * 32;
        q[(long)row * 3072 + col] = f2bf(acc[i][j][rg * 4 + e] * rstd[row]);
      }
    }
  }
};
struct EpKV {
  u16* km; u16* vtm; const float* rstd;
  __device__ __forceinline__ void operator()(f32x16 (&acc)[2][2], int rb, int cb, int col0) const {
#pragma unroll
    EPI_ITER {
      int col = cb + j * 32;
      int row = rb + i * 32 + 8 * rg;
      float v0 = acc[i][j][rg * 4 + 0] * rstd[row], v1 = acc[i][j][rg * 4 + 1] * rstd[row + 1];
      float v2 = acc[i][j][rg * 4 + 2] * rstd[row + 2], v3 = acc[i][j][rg * 4 + 3] * rstd[row + 3];
      if (col0 < 2048) {
        int h = col >> 7, d = col & 127;
        long o = (long)row * 3072 + h * 192 + d;
        km[o] = f2bf(v0); km[o + 3072] = f2bf(v1); km[o + 6144] = f2bf(v2); km[o + 9216] = f2bf(v3);
      } else {
        int c = col - 2048, h = c >> 7, dv = c & 127, b = row >> 11;
        store_T4(vtm + (long)(b * 16 + h) * 128 * 2048, 2048, dv, row, v0, v1, v2, v3);
      }
    }
  }
};
__device__ __forceinline__ float gelu_tanh(float x) {
  float u = 0.7978845608028654f * (x + 0.044715f * x * x * x);
  float t = 1.f - 2.f * __builtin_amdgcn_rcpf(1.f + __builtin_amdgcn_exp2f(2.8853900817779268f * u));
  return 0.5f * x * (1.f + t);
}
struct EpCmp1 {
  u16* h; int ld; const float* bias;
  __device__ __forceinline__ void operator()(f32x16 (&acc)[2][2], int rb, int cb, int col0) const {
#pragma unroll
    EPI_ITER {
      int col = cb + j * 32;
      float bv = bias[col];
#pragma unroll
      for (int e = 0; e < 4; ++e) {
        int row = rb + i * 32 + 8 * rg + e;
        h[(long)row * ld + col] = f2bf(gelu_tanh(acc[i][j][rg * 4 + e] + bv));
      }
    }
  }
};
struct EpCmp2K {
  float* kraw; const float* b2;
  __device__ __forceinline__ void operator()(f32x16 (&acc)[2][2], int rb, int cb, int col0) const {
#pragma unroll
    EPI_ITER {
      int col = cb + j * 32;
      if (col < 192) {
        float bv = b2[col];
#pragma unroll
        for (int e = 0; e < 4; ++e) {
          int row = rb + i * 32 + 8 * rg + e;
          kraw[(long)row * 192 + col] = acc[i][j][rg * 4 + e] + bv;
        }
      }
    }
  }
};
struct EpCmp2V {
  u16* vct; const float* b2;
  __device__ __forceinline__ void operator()(f32x16 (&acc)[2][2], int rb, int cb, int col0) const {
#pragma unroll
    EPI_ITER {
      int dv = cb + j * 32;
      int row = rb + i * 32 + 8 * rg;
      float bv = b2[dv];
      int bg = row >> 7, c = row & 127;
      uint2 o; o.x = pack2(acc[i][j][rg * 4 + 0] + bv, acc[i][j][rg * 4 + 1] + bv);
      o.y = pack2(acc[i][j][rg * 4 + 2] + bv, acc[i][j][rg * 4 + 3] + bv);
      *(uint2*)(vct + ((long)bg * 128 + dv) * 128 + vpos(c)) = o;
    }
  }
};
template <int MODE>
struct EpY {
  u16* m; const u16* gm;
  __device__ __forceinline__ void operator()(f32x16 (&acc)[2][2], int rb, int cb, int col0) const {
#pragma unroll
    EPI_ITER {
#pragma unroll
      for (int e = 0; e < 4; ++e) {
        int row = rb + i * 32 + 8 * rg + e, col = cb + j * 32;
        float v = bf2f(gm[(long)row * 4096 + MODE * 2048 + col]) * acc[i][j][rg * 4 + e];
        if (MODE == 1) v += bf2f(m[(long)row * 2048 + col]);
        m[(long)row * 2048 + col] = f2bf(v);
      }
    }
  }
};
struct EpOut {
  float* out; const float* x;
  __device__ __forceinline__ void operator()(f32x16 (&acc)[2][2], int rb, int cb, int col0) const {
#pragma unroll
    EPI_ITER {
#pragma unroll
      for (int e = 0; e < 4; ++e) {
        long o = (long)(rb + i * 32 + 8 * rg + e) * 2048 + cb + j * 32;
        out[o] = x[o] + acc[i][j][rg * 4 + e];
      }
    }
  }
};
struct EpFfn1 {
  u16* act; const float* rstd;
  __device__ __forceinline__ void operator()(f32x16 (&acc)[2][2], int rb, int cb, int col0) const {
    int u = (col0 >> 7) * 64 + ((cb - col0) >> 6) * 32 + ((cb - col0) & 31);
#pragma unroll
    for (int i = 0; i < 2; ++i)
#pragma unroll
      for (int rg = 0; rg < 4; ++rg)
#pragma unroll
        for (int e = 0; e < 4; ++e) {
          int row = rb + i * 32 + 8 * rg + e;
          float rs = rstd[row];
          float g = acc[i][0][rg * 4 + e] * rs, up = acc[i][1][rg * 4 + e] * rs;
          act[(long)row * 5632 + u] = f2bf(g * sigmoidf_(g) * up);
        }
  }
};
struct EpFfn2 {
  float* out;
  __device__ __forceinline__ void operator()(f32x16 (&acc)[2][2], int rb, int cb, int col0) const {
#pragma unroll
    EPI_ITER {
#pragma unroll
      for (int e = 0; e < 4; ++e) {
        long o = (long)(rb + i * 32 + 8 * rg + e) * 2048 + cb + j * 32;
        out[o] = out[o] + acc[i][j][rg * 4 + e];
      }
    }
  }
};

typedef __attribute__((ext_vector_type(4))) float f32x4;
#define G8_HT 8192
__device__ __forceinline__ int g8_lds_byte(int r, int c) {
  int st = (r >> 4) * 2 + (c >> 5), rr = r & 15, cc = c & 31, ob = rr * 64 + cc * 2;
  return st * 1024 + (ob ^ (((ob >> 9) & 1) << 5));
}
__device__ __forceinline__ void g8_stage_rc(int b, int& R, int& C) {
  int st = b / 1024, sb = b % 1024, swz = sb ^ (((sb >> 9) & 1) << 5);
  R = (st >> 1) * 16 + swz / 64; C = (st & 1) * 32 + (swz % 64) / 2;
}

__device__ __forceinline__ const char* uniform_ptr(const char* p) {
  unsigned long long v = (unsigned long long)p;
  unsigned lo = __builtin_amdgcn_readfirstlane((unsigned)v), hi = __builtin_amdgcn_readfirstlane((unsigned)(v >> 32));
  return (const char*)(((unsigned long long)hi << 32) | lo);
}
template <class AF, class EP>
__device__ __forceinline__ void gemm8_tile(char* smem, AF aptr, const u16* __restrict__ Bt, long ldb, int ktb, int nt,
                                           int brow, int bcol, EP& epi) {
  u16* shm = (u16*)smem;
#define SA(b, h) (shm + ((b) * 2 + (h)) * G8_HT)
#define SB(b, h) (shm + (4 + (b) * 2 + (h)) * G8_HT)
#define STAGE_A(P, hf, kt) do { const char* ab_ = uniform_ptr((const char*)(aptr.A + aptr.koff((kt) + ktb))); \
    __builtin_amdgcn_global_load_lds((const unsigned*)(ab_ + aoff[hf][0]), (unsigned*)((char*)(P) + sb0), 16, 0, 0); \
    __builtin_amdgcn_global_load_lds((const unsigned*)(ab_ + aoff[hf][1]), (unsigned*)((char*)(P) + sb0 + 8192), 16, 0, 0); } while (0)
#define STAGE_B(P, hf, kt) do { const char* bb_ = uniform_ptr((const char*)(Bt + (long)(bcol + (hf) * 128) * ldb + (long)((kt) + ktb) * 64)); \
    __builtin_amdgcn_global_load_lds((const unsigned*)(bb_ + boff0), (unsigned*)((char*)(P) + sb0), 16, 0, 0); \
    __builtin_amdgcn_global_load_lds((const unsigned*)(bb_ + boff1), (unsigned*)((char*)(P) + sb0 + 8192), 16, 0, 0); } while (0)
#define LDA(dst, b, h) for (int m = 0; m < 4; ++m) for (int k = 0; k < 2; ++k) \
    dst[m][k] = *reinterpret_cast<const bf16x8*>((char*)SA(b, h) + g8_lds_byte(wr * 64 + m * 16 + fr, k * 32 + fq * 8))
#define LDB(dst, b, h) for (int n = 0; n < 2; ++n) for (int k = 0; k < 2; ++k) \
    dst[n][k] = *reinterpret_cast<const bf16x8*>((char*)SB(b, h) + g8_lds_byte(wc * 32 + n * 16 + fr, k * 32 + fq * 8))
#define MMA(ai, bj, At_, Bt_) do { __builtin_amdgcn_s_setprio(1); \
    for (int m = 0; m < 4; ++m) for (int n = 0; n < 2; ++n) for (int k = 0; k < 2; ++k) \
      acc[ai][bj][m][n] = __builtin_amdgcn_mfma_f32_16x16x32_bf16(At_[m][k], Bt_[n][k], acc[ai][bj][m][n], 0, 0, 0); \
    __builtin_amdgcn_s_setprio(0); } while (0)
#define WAIT_V(n) asm volatile("s_waitcnt vmcnt(" #n ")" ::: "memory")
#define WAIT_L(n) asm volatile("s_waitcnt lgkmcnt(" #n ")" ::: "memory")
#define BAR __builtin_amdgcn_s_barrier()
#define SCHED __builtin_amdgcn_sched_barrier(0)
  const int HALF = 128;
  int tid = threadIdx.x;
  asm volatile("" : "+v"(tid));
  const int wid = tid >> 6, lane = tid & 63, wr = wid >> 2, wc = wid & 3, fr = lane & 15, fq = lane >> 4;
  const int sb0 = tid * 16;
  int sR0, sC0, sR1, sC1;
  g8_stage_rc(sb0, sR0, sC0);
  g8_stage_rc(sb0 + 8192, sR1, sC1);
  unsigned aoff[2][2];
  aoff[0][0] = (aptr.rowoff(brow + sR0) + sC0) * 2u; aoff[0][1] = (aptr.rowoff(brow + sR1) + sC1) * 2u;
  aoff[1][0] = (aptr.rowoff(brow + 128 + sR0) + sC0) * 2u; aoff[1][1] = (aptr.rowoff(brow + 128 + sR1) + sC1) * 2u;
  const unsigned boff0 = (unsigned)(sR0 * (int)ldb + sC0) * 2u, boff1 = (unsigned)(sR1 * (int)ldb + sC1) * 2u;
  f32x4 acc[2][2][4][2];
#pragma unroll
  for (int a = 0; a < 2; ++a)
#pragma unroll
    for (int b = 0; b < 2; ++b)
#pragma unroll
      for (int m = 0; m < 4; ++m)
#pragma unroll
        for (int n = 0; n < 2; ++n) acc[a][b][m][n] = f32x4{0.f, 0.f, 0.f, 0.f};
  bf16x8 At[4][2], B0[2][2], B1[2][2];
  STAGE_B(SB(0, 0), 0, 0); STAGE_A(SA(0, 0), 0, 0);
  STAGE_B(SB(0, 1), 1, 0); STAGE_A(SA(0, 1), 1, 0);
  if (wr == 1) BAR;
  WAIT_V(4); BAR;
  STAGE_B(SB(1, 0), 0, 1); STAGE_A(SA(1, 0), 0, 1); STAGE_B(SB(1, 1), 1, 1);
  WAIT_V(6); BAR;
  for (int t = 0; t < nt - 2; t += 2) {
#pragma unroll
    LDB(B0, 0, 0); SCHED;
#pragma unroll
    LDA(At, 0, 0); STAGE_A(SA(1, 1), 1, t + 1);
    WAIT_L(8); BAR; WAIT_L(0);
#pragma unroll
    MMA(0, 0, At, B0); BAR; SCHED;
#pragma unroll
    LDB(B1, 0, 1); STAGE_B(SB(0, 0), 0, t + 2);
    BAR; WAIT_L(0);
#pragma unroll
    MMA(0, 1, At, B1); BAR;
#pragma unroll
    LDA(At, 0, 1); STAGE_A(SA(0, 0), 0, t + 2);
    BAR; WAIT_L(0);
#pragma unroll
    MMA(1, 0, At, B0); BAR; SCHED;
    STAGE_B(SB(0, 1), 1, t + 2);
    WAIT_V(6); BAR;
#pragma unroll
    MMA(1, 1, At, B1); BAR;
#pragma unroll
    LDB(B0, 1, 0); SCHED;
#pragma unroll
    LDA(At, 1, 0); STAGE_A(SA(0, 1), 1, t + 2);
    WAIT_L(8); BAR; WAIT_L(0);
#pragma unroll
    MMA(0, 0, At, B0); BAR; SCHED;
#pragma unroll
    LDB(B1, 1, 1); STAGE_B(SB(1, 0), 0, t + 3);
    BAR; WAIT_L(0);
#pragma unroll
    MMA(0, 1, At, B1); BAR;
#pragma unroll
    LDA(At, 1, 1); STAGE_A(SA(1, 0), 0, t + 3);
    BAR; WAIT_L(0);
#pragma unroll
    MMA(1, 0, At, B0); BAR; SCHED;
    STAGE_B(SB(1, 1), 1, t + 3);
    WAIT_V(6); BAR;
#pragma unroll
    MMA(1, 1, At, B1); BAR;
  }
  {
#pragma unroll
    LDB(B0, 0, 0);
#pragma unroll
    LDA(At, 0, 0); STAGE_A(SA(1, 1), 1, nt - 1);
    BAR; WAIT_L(0);
#pragma unroll
    MMA(0, 0, At, B0); BAR;
#pragma unroll
    LDB(B1, 0, 1); BAR; WAIT_L(0);
#pragma unroll
    MMA(0, 1, At, B1); BAR;
#pragma unroll
    LDA(At, 0, 1); WAIT_V(4); BAR; WAIT_L(0);
#pragma unroll
    MMA(1, 0, At, B0);
#pragma unroll
    MMA(1, 1, At, B1); BAR;
  }
  {
#pragma unroll
    LDB(B0, 1, 0);
#pragma unroll
    LDA(At, 1, 0); WAIT_V(2); BAR; WAIT_L(0);
#pragma unroll
    MMA(0, 0, At, B0); BAR;
#pragma unroll
    LDB(B1, 1, 1); WAIT_V(0); BAR; WAIT_L(0);
#pragma unroll
    MMA(0, 1, At, B1); BAR;
#pragma unroll
    LDA(At, 1, 1); BAR; WAIT_L(0);
#pragma unroll
    MMA(1, 0, At, B0);
#pragma unroll
    MMA(1, 1, At, B1); BAR;
  }
  if (wr == 0) BAR;
  if constexpr (EP::kind == 2) {
    epi(acc, brow + wr * 64 + fq * 4, bcol + wc * 32 + fr, bcol);
  } else {
    float* T = (float*)smem;
#pragma unroll
    for (int ai = 0; ai < 2; ++ai) {
      __syncthreads();
#pragma unroll
      for (int bj = 0; bj < 2; ++bj)
#pragma unroll
        for (int m = 0; m < 4; ++m)
#pragma unroll
          for (int n = 0; n < 2; ++n)
#pragma unroll
            for (int j = 0; j < 4; ++j)
              T[(wr * 64 + m * 16 + fq * 4 + j) * 260 + bj * 128 + wc * 32 + n * 16 + fr] = acc[ai][bj][m][n][j];
      __syncthreads();
      if constexpr (EP::kind == 0) {
#pragma unroll
        for (int q = 0; q < 8; ++q) {
          int id = tid + q * 512, r = id >> 5, c8 = (id & 31) * 8;
          float4 a = *(const float4*)(T + r * 260 + c8), b = *(const float4*)(T + r * 260 + c8 + 4);
          float v[8] = {a.x, a.y, a.z, a.w, b.x, b.y, b.z, b.w};
          epi.row8(brow + ai * 128 + r, bcol + c8, bcol, v);
        }
      } else {
#pragma unroll
        for (int q = 0; q < 4; ++q) {
          int id = tid + q * 512, r = id >> 4, c8 = (id & 15) * 8;
          float4 a = *(const float4*)(T + r * 260 + c8), b = *(const float4*)(T + r * 260 + c8 + 4);
          float4 c = *(const float4*)(T + r * 260 + 128 + c8), d = *(const float4*)(T + r * 260 + 128 + c8 + 4);
          float g[8] = {a.x, a.y, a.z, a.w, b.x, b.y, b.z, b.w};
          float u[8] = {c.x, c.y, c.z, c.w, d.x, d.y, d.z, d.w};
          epi.pair8(brow + ai * 128 + r, (bcol >> 1) + c8, g, u);
        }
      }
    }
  }
#undef SA
#undef SB
#undef STAGE_A
#undef STAGE_B
#undef LDA
#undef LDB
#undef MMA
#undef WAIT_V
#undef WAIT_L
#undef BAR
#undef SCHED
}

template <class AF, class EP>
__device__ __forceinline__ void gemm8_phase(char* smem, AF aptr, const u16* Bt, long ldb, int M, int N, int K, EP epi) {
  const int MT = M >> 8, NT = N >> 8;
  const int G = gridDim.x, per = G >> 3;
  const int vblk = ((G & 7) == 0) ? ((int)(blockIdx.x & 7) * per + (int)(blockIdx.x >> 3)) : (int)blockIdx.x;
  for (int t = vblk; t < MT * NT; t += G) {
    int nt = t % NT, mt = t / NT;
    gemm8_tile(smem, aptr, Bt, ldb, 0, K >> 6, mt * 256, nt * 256, epi);
    __syncthreads();
  }
}

#define EPI8 _Pragma("unroll") for (int ai = 0; ai < 2; ++ai) _Pragma("unroll") for (int bj = 0; bj < 2; ++bj) \
             _Pragma("unroll") for (int m = 0; m < 4; ++m) _Pragma("unroll") for (int n = 0; n < 2; ++n)
typedef f32x4 acc8_t[2][2][4][2];

struct Ep8Lat {
  u16* lat; float* gates; const float* rstd;
  __device__ __forceinline__ void operator()(acc8_t& acc, int rb, int cb, int col0) const {
    EPI8 {
      int col = cb + bj * 128 + n * 16;
#pragma unroll
      for (int j = 0; j < 4; ++j) {
        int row = rb + ai * 128 + m * 16 + j;
        float v = acc[ai][bj][m][n][j] * rstd[row];
        if (col < 1088) lat[(long)row * 1280 + col] = f2bf(v);
        else if (col < 1136) gates[(long)row * 48 + (col - 1088)] = sigmoidf_(v);
      }
    }
  }
};
struct Ep8Nsa {
  char* ws; const float* rstd;
  __device__ __forceinline__ void operator()(acc8_t& acc, int rb, int cb, int col0) const {
    u16* rm; int ld, cbase; bool tr = false; u16* tb = nullptr;
    if (col0 < 3072) { rm = (u16*)(ws + OFF_QN); ld = 3072; cbase = 0; }
    else if (col0 < 3840) { rm = (u16*)(ws + OFF_KC); ld = 768; cbase = 3072; }
    else if (col0 < 4352) { rm = (u16*)(ws + OFF_VC); ld = 512; cbase = 3840; }
    else if (col0 < 5120) { rm = (u16*)(ws + OFF_KS); ld = 768; cbase = 4352; }
    else if (col0 < 5632) { tr = true; tb = (u16*)(ws + OFF_VST); rm = nullptr; ld = 0; cbase = 5120; }
    else if (col0 < 6400) { rm = (u16*)(ws + OFF_KW); ld = 768; cbase = 5632; }
    else { tr = true; tb = (u16*)(ws + OFF_VWT); rm = nullptr; ld = 0; cbase = 6400; }
    EPI8 {
      int col = cb + bj * 128 + n * 16 - cbase;
      int row = rb + ai * 128 + m * 16;
      float v0 = acc[ai][bj][m][n][0] * rstd[row], v1 = acc[ai][bj][m][n][1] * rstd[row + 1];
      float v2 = acc[ai][bj][m][n][2] * rstd[row + 2], v3 = acc[ai][bj][m][n][3] * rstd[row + 3];
      if (tr) {
        int b = row >> 11, g = col >> 7, dv = col & 127;
        store_T4(tb + (long)(b * 4 + g) * 128 * 2048, 2048, dv, row, v0, v1, v2, v3);
      } else {
        rm[(long)row * ld + col] = f2bf(v0); rm[(long)(row + 1) * ld + col] = f2bf(v1);
        rm[(long)(row + 2) * ld + col] = f2bf(v2); rm[(long)(row + 3) * ld + col] = f2bf(v3);
      }
    }
  }
};
struct Ep8Gm {
  u16* gm; const float* rstd;
  __device__ __forceinline__ void operator()(acc8_t& acc, int rb, int cb, int col0) const {
    EPI8 {
#pragma unroll
      for (int j = 0; j < 4; ++j) {
        int row = rb + ai * 128 + m * 16 + j, col = cb + bj * 128 + n * 16;
        gm[(long)row * 4096 + col] = f2bf(sigmoidf_(acc[ai][bj][m][n][j] * rstd[row]));
      }
    }
  }
};
struct Ep8Q {
  u16* q; const float* rstd;
  __device__ __forceinline__ void operator()(acc8_t& acc, int rb, int cb, int col0) const {
    EPI8 {
#pragma unroll
      for (int j = 0; j < 4; ++j) {
        int row = rb + ai * 128 + m * 16 + j, col = cb + bj * 128 + n * 16;
        q[(long)row * 3072 + col] = f2bf(acc[ai][bj][m][n][j] * rstd[row]);
      }
    }
  }
};
struct Ep8KV {
  u16* km; u16* vtm; const float* rstd;
  __device__ __forceinline__ void operator()(acc8_t& acc, int rb, int cb, int col0) const {
    EPI8 {
      int col = cb + bj * 128 + n * 16;
      int row = rb + ai * 128 + m * 16;
      float v0 = acc[ai][bj][m][n][0] * rstd[row], v1 = acc[ai][bj][m][n][1] * rstd[row + 1];
      float v2 = acc[ai][bj][m][n][2] * rstd[row + 2], v3 = acc[ai][bj][m][n][3] * rstd[row + 3];
      if (col0 < 2048) {
        int h = col >> 7, d = col & 127;
        long o = (long)row * 3072 + h * 192 + d;
        km[o] = f2bf(v0); km[o + 3072] = f2bf(v1); km[o + 6144] = f2bf(v2); km[o + 9216] = f2bf(v3);
      } else {
        int c = col - 2048, h = c >> 7, dv = c & 127, b = row >> 11;
        store_T4(vtm + (long)(b * 16 + h) * 128 * 2048, 2048, dv, row, v0, v1, v2, v3);
      }
    }
  }
};
struct Ep8Cmp1 {
  u16* h; int ld; const float* bias;
  __device__ __forceinline__ void operator()(acc8_t& acc, int rb, int cb, int col0) const {
    EPI8 {
      int col = cb + bj * 128 + n * 16;
      float bv = bias[col];
#pragma unroll
      for (int j = 0; j < 4; ++j) {
        int row = rb + ai * 128 + m * 16 + j;
        h[(long)row * ld + col] = f2bf(gelu_tanh(acc[ai][bj][m][n][j] + bv));
      }
    }
  }
};
struct Ep8Part {
  float* part; int ld;
  __device__ __forceinline__ void operator()(acc8_t& acc, int rb, int cb, int col0) const {
    EPI8 {
#pragma unroll
      for (int j = 0; j < 4; ++j) {
        int row = rb + ai * 128 + m * 16 + j, col = cb + bj * 128 + n * 16;
        part[(long)row * ld + col] = acc[ai][bj][m][n][j];
      }
    }
  }
};
struct Ep8Cmp2K {
  float* kraw; const float* b2;
  __device__ __forceinline__ void operator()(acc8_t& acc, int rb, int cb, int col0) const {
    EPI8 {
      int col = cb + bj * 128 + n * 16;
      if (col < 192) {
        float bv = b2[col];
#pragma unroll
        for (int j = 0; j < 4; ++j) {
          int row = rb + ai * 128 + m * 16 + j;
          kraw[(long)row * 192 + col] = acc[ai][bj][m][n][j] + bv;
        }
      }
    }
  }
};
struct Ep8Cmp2V {
  static constexpr int kind = 2;
  u16* vct; const float* b2;
  __device__ __forceinline__ void operator()(acc8_t& acc, int rb, int cb, int col0) const {
    EPI8 {
      int dv = cb + bj * 128 + n * 16;
      if (dv < 128) {
        int row = rb + ai * 128 + m * 16;
        float bv = b2[dv];
        int bg = row >> 7, c = row & 127;
        uint2 o; o.x = pack2(acc[ai][bj][m][n][0] + bv, acc[ai][bj][m][n][1] + bv);
        o.y = pack2(acc[ai][bj][m][n][2] + bv, acc[ai][bj][m][n][3] + bv);
        *(uint2*)(vct + ((long)bg * 128 + dv) * 128 + vpos(c)) = o;
      }
    }
  }
};
template <int MODE>
struct Ep8Y {
  u16* mm; const u16* gm;
  __device__ __forceinline__ void operator()(acc8_t& acc, int rb, int cb, int col0) const {
    EPI8 {
#pragma unroll
      for (int j = 0; j < 4; ++j) {
        int row = rb + ai * 128 + m * 16 + j, col = cb + bj * 128 + n * 16;
        float v = bf2f(gm[(long)row * 4096 + MODE * 2048 + col]) * acc[ai][bj][m][n][j];
        if (MODE == 1) v += bf2f(mm[(long)row * 2048 + col]);
        mm[(long)row * 2048 + col] = f2bf(v);
      }
    }
  }
};
struct Ep8Out {
  float* out; const float* x;
  __device__ __forceinline__ void operator()(acc8_t& acc, int rb, int cb, int col0) const {
    EPI8 {
#pragma unroll
      for (int j = 0; j < 4; ++j) {
        long o = (long)(rb + ai * 128 + m * 16 + j) * 2048 + cb + bj * 128 + n * 16;
        out[o] = x[o] + acc[ai][bj][m][n][j];
      }
    }
  }
};
struct Ep8Ffn1 {
  u16* act; const float* rstd;
  __device__ __forceinline__ void operator()(acc8_t& acc, int rb, int cb, int col0) const {
#pragma unroll
    for (int ai = 0; ai < 2; ++ai)
#pragma unroll
      for (int m = 0; m < 4; ++m)
#pragma unroll
        for (int n = 0; n < 2; ++n)
#pragma unroll
          for (int j = 0; j < 4; ++j) {
            int row = rb + ai * 128 + m * 16 + j;
            int u = (col0 >> 8) * 128 + (cb - col0) + n * 16;
            float rs = rstd[row];
            float g = acc[ai][0][m][n][j] * rs, up = acc[ai][1][m][n][j] * rs;
            act[(long)row * 5632 + u] = f2bf(g * sigmoidf_(g) * up);
          }
  }
};
struct Ep8Ffn2 {
  float* out;
  __device__ __forceinline__ void operator()(acc8_t& acc, int rb, int cb, int col0) const {
    EPI8 {
#pragma unroll
      for (int j = 0; j < 4; ++j) {
        long o = (long)(rb + ai * 128 + m * 16 + j) * 2048 + cb + bj * 128 + n * 16;
        out[o] = out[o] + acc[ai][bj][m][n][j];
      }
    }
  }
};

__device__ __forceinline__ uint4 pack8(const float (&v)[8]) {
  uint4 o; o.x = pack2(v[0], v[1]); o.y = pack2(v[2], v[3]); o.z = pack2(v[4], v[5]); o.w = pack2(v[6], v[7]);
  return o;
}
__device__ __forceinline__ void unpack8(uint4 w, float (&v)[8]) {
  v[0] = bf2f((u16)(w.x & 0xffff)); v[1] = bf2f((u16)(w.x >> 16)); v[2] = bf2f((u16)(w.y & 0xffff)); v[3] = bf2f((u16)(w.y >> 16));
  v[4] = bf2f((u16)(w.z & 0xffff)); v[5] = bf2f((u16)(w.z >> 16)); v[6] = bf2f((u16)(w.w & 0xffff)); v[7] = bf2f((u16)(w.w >> 16));
}
struct R8Lat {
  static constexpr int kind = 0;
  u16* lat; float* gates; const float* rstd;
  __device__ __forceinline__ void row8(int row, int col, int col0, float (&v)[8]) const {
    float rs = rstd[row];
#pragma unroll
    for (int i = 0; i < 8; ++i) v[i] *= rs;
    if (col < 1088) *(uint4*)(lat + (long)row * 1280 + col) = pack8(v);
    else if (col < 1136) {
      float* gp = gates + (long)row * 48 + (col - 1088);
      *(float4*)gp = make_float4(sigmoidf_(v[0]), sigmoidf_(v[1]), sigmoidf_(v[2]), sigmoidf_(v[3]));
      *(float4*)(gp + 4) = make_float4(sigmoidf_(v[4]), sigmoidf_(v[5]), sigmoidf_(v[6]), sigmoidf_(v[7]));
    }
  }
};
struct R8NsaRM {
  static constexpr int kind = 0;
  char* ws; const float* rstd;
  __device__ __forceinline__ void row8(int row, int col, int col0, float (&v)[8]) const {
    u16* rm; int ld, cbase;
    if (col0 < 3072) { rm = (u16*)(ws + OFF_QN); ld = 3072; cbase = 0; }
    else if (col0 < 3840) { rm = (u16*)(ws + OFF_KC); ld = 768; cbase = 3072; }
    else if (col0 < 4352) { rm = (u16*)(ws + OFF_VC); ld = 512; cbase = 3840; }
    else if (col0 < 5120) { rm = (u16*)(ws + OFF_KS); ld = 768; cbase = 4352; }
    else { rm = (u16*)(ws + OFF_KW); ld = 768; cbase = 5120; }
    float rs = rstd[row];
#pragma unroll
    for (int i = 0; i < 8; ++i) v[i] *= rs;
    *(uint4*)(rm + (long)row * ld + (col - cbase)) = pack8(v);
  }
};
struct D8NsaT {
  static constexpr int kind = 2;
  char* ws; const float* rstd;
  __device__ __forceinline__ void operator()(acc8_t& acc, int rb, int cb, int col0) const {
    u16* tb = (u16*)(ws + (col0 < 512 ? OFF_VST : OFF_VWT));
    int cbase = col0 < 512 ? 0 : 512;
    EPI8 {
      int col = cb + bj * 128 + n * 16 - cbase;
      int row = rb + ai * 128 + m * 16;
      float v0 = acc[ai][bj][m][n][0] * rstd[row], v1 = acc[ai][bj][m][n][1] * rstd[row + 1];
      float v2 = acc[ai][bj][m][n][2] * rstd[row + 2], v3 = acc[ai][bj][m][n][3] * rstd[row + 3];
      int b = row >> 11, g = col >> 7, dv = col & 127;
      store_T4(tb + (long)(b * 4 + g) * 128 * 2048, 2048, dv, row, v0, v1, v2, v3);
    }
  }
};
struct R8Gm {
  static constexpr int kind = 0;
  u16* gm; const float* rstd;
  __device__ __forceinline__ void row8(int row, int col, int col0, float (&v)[8]) const {
    float rs = rstd[row];
#pragma unroll
    for (int i = 0; i < 8; ++i) v[i] = sigmoidf_(v[i] * rs);
    *(uint4*)(gm + (long)row * 4096 + col) = pack8(v);
  }
};
struct R8Q {
  static constexpr int kind = 0;
  u16* q; const float* rstd;
  __device__ __forceinline__ void row8(int row, int col, int col0, float (&v)[8]) const {
    float rs = rstd[row];
#pragma unroll
    for (int i = 0; i < 8; ++i) v[i] *= rs;
    *(uint4*)(q + (long)row * 3072 + col) = pack8(v);
  }
};
__device__ __forceinline__ void ld4(const u16* p, float* v);
struct R8K {
  static constexpr int kind = 0;
  char* ws; const float* g;
  __device__ __forceinline__ void row8(int row, int col, int col0, float (&v)[8]) const {
    u16* km = (u16*)(ws + OFF_KM); const float* rstd = (const float*)(ws + OFF_RSTD_CKV);
    const u16* lat = (const u16*)(ws + OFF_LAT);
    const float* cosm = (const float*)(ws + OFF_COSM); const float* sinm = (const float*)(ws + OFF_SINM);
    const int hl = (threadIdx.x & 15);
    const int h = col >> 7;
    const float rsk = rstd[row];
#pragma unroll
    for (int i = 0; i < 8; ++i) v[i] *= rsk;
    float kr[4];
    ld4(lat + (long)row * 1280 + 1024 + hl * 4, kr);
    float ss = 0.f;
#pragma unroll
    for (int i = 0; i < 8; ++i) ss += v[i] * v[i];
#pragma unroll
    for (int e = 0; e < 4; ++e) ss += kr[e] * kr[e];
    ss += __shfl_xor(ss, 1); ss += __shfl_xor(ss, 2); ss += __shfl_xor(ss, 4); ss += __shfl_xor(ss, 8);
    const float rs = rsqrtf(ss * (1.f / 192.f) + 1e-6f);
    const float4 ga = *(const float4*)(g + hl * 8), gb = *(const float4*)(g + hl * 8 + 4);
    v[0] *= rs * ga.x; v[1] *= rs * ga.y; v[2] *= rs * ga.z; v[3] *= rs * ga.w;
    v[4] *= rs * gb.x; v[5] *= rs * gb.y; v[6] *= rs * gb.z; v[7] *= rs * gb.w;
    u16* kp = km + (long)row * 3072 + h * 192;
    *(uint4*)(kp + hl * 8) = pack8(v);
    const float4 gr = *(const float4*)(g + 128 + hl * 4);
    float y[4] = {kr[0] * rs * gr.x, kr[1] * rs * gr.y, kr[2] * rs * gr.z, kr[3] * rs * gr.w};
    const int t = row & 2047, i0 = (hl & 7) * 4;
    const float4 cc = *(const float4*)(cosm + t * 32 + i0), sn = *(const float4*)(sinm + t * 32 + i0);
    float pz[4];
#pragma unroll
    for (int e = 0; e < 4; ++e) pz[e] = __shfl_xor(y[e], 8);
    const float sg = (hl < 8) ? -1.f : 1.f;
    float o0 = y[0] * cc.x + sg * pz[0] * sn.x, o1 = y[1] * cc.y + sg * pz[1] * sn.y;
    float o2 = y[2] * cc.z + sg * pz[2] * sn.z, o3 = y[3] * cc.w + sg * pz[3] * sn.w;
    uint2 o; o.x = pack2(o0, o1); o.y = pack2(o2, o3);
    *(uint2*)(kp + 128 + hl * 4) = o;
  }
};
struct D8V {
  static constexpr int kind = 2;
  u16* vtm; const float* rstd;
  __device__ __forceinline__ void operator()(acc8_t& acc, int rb, int cb, int col0) const {
    EPI8 {
      int c = cb + bj * 128 + n * 16;
      int row = rb + ai * 128 + m * 16;
      float v0 = acc[ai][bj][m][n][0] * rstd[row], v1 = acc[ai][bj][m][n][1] * rstd[row + 1];
      float v2 = acc[ai][bj][m][n][2] * rstd[row + 2], v3 = acc[ai][bj][m][n][3] * rstd[row + 3];
      int h = c >> 7, dv = c & 127, b = row >> 11;
      store_T4(vtm + (long)(b * 16 + h) * 128 * 2048, 2048, dv, row, v0, v1, v2, v3);
    }
  }
};
struct R8Part {
  static constexpr int kind = 0;
  float* part; int ld;
  __device__ __forceinline__ void row8(int row, int col, int col0, float (&v)[8]) const {
    float* pp = part + (long)row * ld + col;
    *(float4*)pp = make_float4(v[0], v[1], v[2], v[3]);
    *(float4*)(pp + 4) = make_float4(v[4], v[5], v[6], v[7]);
  }
};
struct R8Cmp2K {
  static constexpr int kind = 0;
  float* kraw; const float* b2;
  __device__ __forceinline__ void row8(int row, int col, int col0, float (&v)[8]) const {
    if (col < 192) {
      float* pp = kraw + (long)row * 192 + col;
      *(float4*)pp = make_float4(v[0] + b2[col], v[1] + b2[col + 1], v[2] + b2[col + 2], v[3] + b2[col + 3]);
      *(float4*)(pp + 4) = make_float4(v[4] + b2[col + 4], v[5] + b2[col + 5], v[6] + b2[col + 6], v[7] + b2[col + 7]);
    }
  }
};
template <int MODE>
struct R8Y {
  static constexpr int kind = 0;
  u16* mm; const u16* gm;
  __device__ __forceinline__ void row8(int row, int col, int col0, float (&v)[8]) const {
    float g[8];
    unpack8(*(const uint4*)(gm + (long)row * 4096 + MODE * 2048 + col), g);
#pragma unroll
    for (int i = 0; i < 8; ++i) v[i] *= g[i];
    if (MODE == 1) {
      float o[8];
      unpack8(*(const uint4*)(mm + (long)row * 2048 + col), o);
#pragma unroll
      for (int i = 0; i < 8; ++i) v[i] += o[i];
    }
    *(uint4*)(mm + (long)row * 2048 + col) = pack8(v);
  }
};
struct R8Out {
  static constexpr int kind = 0;
  u16* hb; const float* x; float* sspart;
  __device__ __forceinline__ void row8(int row, int col, int col0, float (&v)[8]) const {
    long o = (long)row * 2048 + col;
    float4 a = ld_nt4(x + o), b = ld_nt4(x + o + 4);
    v[0] += a.x; v[1] += a.y; v[2] += a.z; v[3] += a.w; v[4] += b.x; v[5] += b.y; v[6] += b.z; v[7] += b.w;
    float ss = 0.f;
#pragma unroll
    for (int i = 0; i < 8; ++i) ss += v[i] * v[i];
    ss = half_sum(ss);
    if ((threadIdx.x & 31) == 0) sspart[row * 8 + (col0 >> 8)] = ss;
    *(uint4*)(hb + o) = pack8(v);
  }
};
struct R8Ffn1 {
  static constexpr int kind = 1;
  u16* act; const float* rstd;
  __device__ __forceinline__ void pair8(int row, int u0, float (&g)[8], float (&u)[8]) const {
    float rs = rstd[row];
    float o[8];
#pragma unroll
    for (int i = 0; i < 8; ++i) { float gg = g[i] * rs; o[i] = gg * sigmoidf_(gg) * (u[i] * rs); }
    *(uint4*)(act + (long)row * 5632 + u0) = pack8(o);
  }
};
struct R8Ffn2 {
  static constexpr int kind = 0;
  float* out; const u16* hb;
  __device__ __forceinline__ void row8(int row, int col, int col0, float (&v)[8]) const {
    long o = (long)row * 2048 + col;
    float h[8];
    unpack8(*(const uint4*)(hb + o), h);
    st_nt4(out + o, h[0] + v[0], h[1] + v[1], h[2] + v[2], h[3] + v[3]);
    st_nt4(out + o + 4, h[4] + v[4], h[5] + v[5], h[6] + v[6], h[7] + v[7]);
  }
};

__device__ __forceinline__ void phase_latnorm(const u16* __restrict__ lat, float* rcq, float* rckv) {
  const int lane = threadIdx.x & 63;
  const int wave = (blockIdx.x * 512 + threadIdx.x) >> 6, nw = gridDim.x * 8;
  for (int it = wave; it < NTOK * 2; it += nw) {
    int row = it >> 1, which = it & 1;
    uint4 v = *(const uint4*)(lat + (long)row * 1280 + which * 512 + lane * 8);
    unsigned w[4] = {v.x, v.y, v.z, v.w};
    float ss = 0.f;
#pragma unroll
    for (int i = 0; i < 4; ++i) {
      float a = bf2f((u16)(w[i] & 0xffff)), b = bf2f((u16)(w[i] >> 16));
      ss += a * a + b * b;
    }
    ss = wave_sum(ss);
    if (lane == 0) (which ? rckv : rcq)[row] = rsqrtf(ss * (1.f / 512.f) + 1e-6f);
  }
}

template <int KIND>
__device__ __forceinline__ void norm_rope_vec(float (&v)[6], const float* __restrict__ g, const float* __restrict__ cosr,
                                              const float* __restrict__ sinr, int li) {
  float ss = 0.f;
#pragma unroll
  for (int i = 0; i < 6; ++i) ss += v[i] * v[i];
  ss = half_sum(ss);
  float rs = rsqrtf(ss * (1.f / 192.f) + 1e-6f);
  float4 g0 = *(const float4*)(g + 4 * li);
  float2 g1 = *(const float2*)(g + 128 + 2 * li);
  v[0] *= rs * g0.x; v[1] *= rs * g0.y; v[2] *= rs * g0.z; v[3] *= rs * g0.w;
  v[4] *= rs * g1.x; v[5] *= rs * g1.y;
  if (KIND == 0) {
    float p0 = __shfl_xor(v[4], 16), p1 = __shfl_xor(v[5], 16);
    int i0 = (2 * li) & 31;
    float c0 = cosr[i0], s0 = sinr[i0], c1 = cosr[i0 + 1], s1 = sinr[i0 + 1];
    if (li < 16) { v[4] = v[4] * c0 - p0 * s0; v[5] = v[5] * c1 - p1 * s1; }
    else { v[4] = v[4] * c0 + p0 * s0; v[5] = v[5] * c1 + p1 * s1; }
  } else {
    int lane = threadIdx.x & 63;
    int src = (li < 6) ? (lane + 6) : (lane - 6);
    src &= 63;
    float p[4];
#pragma unroll
    for (int e = 0; e < 4; ++e) p[e] = __shfl(v[e], src);
    if (li < 12) {
      int i0 = (li < 6) ? 4 * li : 4 * li - 24;
      float sg = (li < 6) ? -1.f : 1.f;
#pragma unroll
      for (int e = 0; e < 4; ++e) v[e] = v[e] * cosr[i0 + e] + sg * p[e] * sinr[i0 + e];
    }
  }
}
__device__ __forceinline__ void ld4(const u16* p, float* v) {
  uint2 w = *(const uint2*)p;
  v[0] = bf2f((u16)(w.x & 0xffff)); v[1] = bf2f((u16)(w.x >> 16));
  v[2] = bf2f((u16)(w.y & 0xffff)); v[3] = bf2f((u16)(w.y >> 16));
}
__device__ __forceinline__ void ld2(const u16* p, float& a, float& b) {
  unsigned w = *(const unsigned*)p; a = bf2f((u16)(w & 0xffff)); b = bf2f((u16)(w >> 16));
}
__device__ __forceinline__ void st6(u16* base, const float (&v)[6], int li) {
  uint2 o; o.x = pack2(v[0], v[1]); o.y = pack2(v[2], v[3]);
  *(uint2*)(base + 4 * li) = o;
  *(unsigned*)(base + 128 + 2 * li) = pack2(v[4], v[5]);
}

__device__ __forceinline__ void phase_mla_rope(const Params& p, bool probe = false) {
  char* ws = p.ws;
  u16* qm = (u16*)p.out;
  u16* km = (u16*)(ws + OFF_KM);
  const u16* lat = (const u16*)(ws + OFF_LAT);
  const float* cosm = (const float*)(ws + OFF_COSM); const float* sinm = (const float*)(ws + OFF_SINM);
  const int li = threadIdx.x & 31;
  const long hw = ((long)blockIdx.x * 512 + threadIdx.x) >> 5, nhw = (long)gridDim.x * 16;
  const long total = (long)NTOK * 16;
  for (long it0 = hw; it0 < total; it0 += 2 * nhw) {
    const bool hasB = it0 + nhw < total;
    const long itA = it0, itB = hasB ? it0 + nhw : it0;
    const int whA = 1, whB = 1;
    const long rowA = itA >> 4, rowB = itB >> 4;
    const int hA = (int)(itA & 15), hB = (int)(itB & 15);
    u16* baseA = (whA ? km : qm) + rowA * 3072 + hA * 192;
    u16* baseB = (whB ? km : qm) + rowB * 3072 + hB * 192;
    const u16* pA = whA ? (lat + rowA * 1280 + 1024 + 2 * li) : (const u16*)(baseA + 128 + 2 * li);
    const u16* pB = whB ? (lat + rowB * 1280 + 1024 + 2 * li) : (const u16*)(baseB + 128 + 2 * li);
    float vA[6], vB[6];
    ld4(baseA + 4 * li, vA); ld2(pA, vA[4], vA[5]);
    ld4(baseB + 4 * li, vB); ld2(pB, vB[4], vB[5]);
    const int tA = (int)(rowA & 2047), tB = (int)(rowB & 2047);
    norm_rope_vec<0>(vA, whA ? p.in[9] : p.in[8], cosm + tA * 32, sinm + tA * 32, li);
    norm_rope_vec<0>(vB, whB ? p.in[9] : p.in[8], cosm + tB * 32, sinm + tB * 32, li);
    if (probe) {
      u16* scr = (u16*)(ws + ACT + 264 * MIB);
      st6(scr + (rowA * 3072 + hA * 192), vA, li);
      if (hasB) st6(scr + (rowB * 3072 + hB * 192), vB, li);
    } else {
      st6(baseA, vA, li);
      if (hasB) st6(baseB, vB, li);
    }
  }
}

__device__ __forceinline__ void phase_nsa_rope(const Params& p, bool probe = false, int blk_first = 0) {
  char* ws = p.ws;
  u16* qn = (u16*)(ws + OFF_QN); u16* ks = (u16*)(ws + OFF_KS); u16* kw = (u16*)(ws + OFF_KW);
  const float* cosn = (const float*)(ws + OFF_COSN); const float* sinn = (const float*)(ws + OFF_SINN);
  const int li = threadIdx.x & 31;
  const long hw = ((long)((int)blockIdx.x - blk_first) * 512 + threadIdx.x) >> 5, nhw = (long)((int)gridDim.x - blk_first) * 16;
  const long total = (long)NTOK * 8;
  for (long it0 = hw; it0 < total; it0 += 2 * nhw) {
    float v[2][6]; u16* base[2]; int tq[2]; const float* gg[2];
#pragma unroll
    for (int u = 0; u < 2; ++u) {
      long it = it0 + u * nhw; if (it >= total) it = it0;
      long row = it >> 3; int s = (int)(it & 7);
      tq[u] = (int)(row & 2047);
      if (s < 4) { base[u] = ks + row * 768 + s * 192; gg[u] = p.in[11] + 192; }
      else { base[u] = kw + row * 768 + (s - 4) * 192; gg[u] = p.in[11] + 384; }
      ld4(base[u] + 4 * li, v[u]);
      ld2(base[u] + 128 + 2 * li, v[u][4], v[u][5]);
    }
#pragma unroll
    for (int u = 0; u < 2; ++u) norm_rope_vec<1>(v[u], gg[u], cosn + tq[u] * 24, sinn + tq[u] * 24, li);
#pragma unroll
    for (int u = 0; u < 2; ++u) if (u == 0 || it0 + nhw < total) {
      if (probe) st6((u16*)(ws + OFF_HB) + (base[u] - (u16*)(ws + OFF_QN)) % (32 * 1024 * 1024), v[u], li);
      else st6(base[u], v[u], li);
    }
  }
}

__device__ __forceinline__ void bias1_reduce(const Params& p) {
  char* ws = p.ws;
  const float* part = (const float*)(ws + OFF_BPART);
  float* bias1 = (float*)(ws + OFF_BIAS1);
  const int lane = threadIdx.x & 63;
  const int wave = (blockIdx.x * 512 + threadIdx.x) >> 6, nw = gridDim.x * 8;
  for (int n = wave; n < 1280; n += nw) {
    float sacc = part[lane * 1280 + n] + part[(lane + 64) * 1280 + n];
    sacc = wave_sum(sacc);
    if (lane == 0) bias1[n] = sacc + ((n < 768) ? p.in[15][n] : p.in[19][n - 768]);
  }
}

__device__ __forceinline__ void phase_cmp_norm(const Params& p) {
  char* ws = p.ws;
  const float* kraw = (const float*)(ws + OFF_KCRAW);
  u16* kcn = (u16*)(ws + OFF_KCN);
  const float* cosn = (const float*)(ws + OFF_COSN); const float* sinn = (const float*)(ws + OFF_SINN);
  const int li = threadIdx.x & 31;
  const long hw = ((long)blockIdx.x * 512 + threadIdx.x) >> 5, nhw = (long)gridDim.x * 16;
  for (long row = hw; row < 4096; row += nhw) {
    int c = (int)(row & 127);
    int pos = 16 * c + 31; if (pos > 2047) pos = 2047;
    const float* src = kraw + row * 192;
    float v[6];
    float4 a = *(const float4*)(src + 4 * li); float2 b2 = *(const float2*)(src + 128 + 2 * li);
    v[0] = a.x; v[1] = a.y; v[2] = a.z; v[3] = a.w; v[4] = b2.x; v[5] = b2.y;
    norm_rope_vec<1>(v, p.in[11], cosn + pos * 24, sinn + pos * 24, li);
    if (c == 127) { v[0] = v[1] = v[2] = v[3] = v[4] = v[5] = 0.f; }
    st6(kcn + row * 192, v, li);
  }
}

#define ATT_STAGE 40960
#define ATT_VOFF 24576
#define ATT_IMP 81920
#define ATT_IMPE 114688
#define ATT_SCORE 147456
#define ATT_MASK 155648

__device__ __forceinline__ void attn_S1(const char* Ks, int k2, const bf16x8 (&Q)[12], f32x16& S, int l31, int hh) {
#pragma unroll
  for (int r = 0; r < 16; ++r) S[r] = 0.f;
#pragma unroll
  for (int ks = 0; ks < 12; ++ks) {
    int r = k2 * 32 + l31, c = ks * 2 + hh;
    bf16x8 a = *(const bf16x8*)(Ks + r * 384 + (((c & ~7) | ((c & 7) ^ ((r >> 1) & 7))) << 4));
    S = __builtin_amdgcn_mfma_f32_32x32x16_bf16(a, Q[ks], S, 0, 0, 0);
  }
}

typedef __attribute__((ext_vector_type(4))) unsigned u32x4;
__device__ __forceinline__ float sm_prep(const bool MASKED, f32x16& S, int k2, f32x16 (&O)[4], float& m, float& l, int key0,
                                         int lo, int hi, float sc, int hh) {
  if (MASKED) {
#pragma unroll
    for (int r = 0; r < 16; ++r) {
      int key = key0 + k2 * 32 + (r & 3) + 8 * (r >> 2) + 4 * hh;
      S[r] = (key >= lo && key <= hi) ? S[r] : -1e30f;
    }
  }
  float mx = fmaxf(fmaxf(fmaxf(S[0], S[1]), fmaxf(S[2], S[3])), fmaxf(fmaxf(S[4], S[5]), fmaxf(S[6], S[7])));
  float mx2 = fmaxf(fmaxf(fmaxf(S[8], S[9]), fmaxf(S[10], S[11])), fmaxf(fmaxf(S[12], S[13]), fmaxf(S[14], S[15])));
  mx = fmaxf(mx, mx2);
  {
    const unsigned u = __float_as_uint(mx);
    auto sw = __builtin_amdgcn_permlane32_swap(u, u, false, false);
    mx = fmaxf(__uint_as_float(sw[0]), __uint_as_float(sw[1]));
  }
  if (!__all((mx - m) * sc <= 11.5416f)) {
    const float mnew = fmaxf(m, mx);
    float alpha = __builtin_amdgcn_exp2f((m - mnew) * sc);
    l *= alpha;
#pragma unroll
    for (int d = 0; d < 4; ++d)
#pragma unroll
      for (int r = 0; r < 16; ++r) O[d][r] *= alpha;
    m = mnew;
  }
  return (m > -1e29f) ? m * sc : 0.f;
}
typedef __attribute__((ext_vector_type(4))) unsigned u32x4;
__device__ __forceinline__ void sm_exp(const f32x16& S, float ms, float sc, u32x4 (&Pw)[2], float& l) {
  float psum = 0.f;
#pragma unroll
  for (int r = 0; r < 16; r += 2) {
    float p0 = __builtin_amdgcn_exp2f(fmaf(S[r], sc, -ms));
    float p1 = __builtin_amdgcn_exp2f(fmaf(S[r + 1], sc, -ms));
    psum += p0 + p1;
    Pw[r >> 3][(r & 7) >> 1] = pack2(p0, p1);
  }
  l += psum;
}
__device__ __forceinline__ void sm_pv(const u32x4 (&Pw)[2], const char* Vs, int k2, f32x16 (&O)[4], int l31, int hh) {
#pragma unroll
  for (int s2 = 0; s2 < 2; ++s2) {
    bf16x8 Pf = __builtin_bit_cast(bf16x8, Pw[s2]);
#pragma unroll
    for (int d = 0; d < 4; ++d) {
      int r = d * 32 + l31, c = (k2 * 2 + s2) * 2 + hh;
      bf16x8 a = *(const bf16x8*)(Vs + r * 128 + ((c ^ ((r >> 1) & 7)) << 4));
      O[d] = __builtin_amdgcn_mfma_f32_32x32x16_bf16(a, Pf, O[d], 0, 0, 0);
    }
  }
}
__device__ __forceinline__ void s_chain(const char* Ks, int k2, const bf16x8 (&Q)[12], f32x16& S, int l31, int hh) {
  const int r = k2 * 32 + l31;
  const char* rowp = Ks + r * 384;
  const int sw = (r >> 1) & 7;
#pragma unroll
  for (int ks = 0; ks < 12; ++ks) {
    const int c = ks * 2 + hh;
    bf16x8 a = *(const bf16x8*)(rowp + (((c & ~7) | ((c & 7) ^ sw)) << 4));
    S = __builtin_amdgcn_mfma_f32_32x32x16_bf16(a, Q[ks], S, 0, 0, 0);
  }
}

__device__ __forceinline__ void flash_step(const char* Ks, const char* Vs, const bf16x8 (&Q)[12], f32x16 (&O)[4], float& m,
                                           float& l, int key0, int lo, int hi, float sc, int l31, int hh) {
  const bool masked = !__all(lo <= key0 && hi >= key0 + 63);
  f32x16 S0, S1;
#pragma unroll
  for (int r = 0; r < 16; ++r) { S0[r] = 0.f; S1[r] = 0.f; }
  u32x4 P0[2], P1[2];
  s_chain(Ks, 0, Q, S0, l31, hh);
  const float ms0 = sm_prep(masked, S0, 0, O, m, l, key0, lo, hi, sc, hh);
  s_chain(Ks, 1, Q, S1, l31, hh);
  sm_exp(S0, ms0, sc, P0, l);
#pragma unroll
  for (int i = 0; i < 12; ++i) {
    __builtin_amdgcn_sched_group_barrier(0x100, 1, 0);
    __builtin_amdgcn_sched_group_barrier(0x008, 1, 0);
    __builtin_amdgcn_sched_group_barrier(0x002, 5, 0);
  }
  sm_pv(P0, Vs, 0, O, l31, hh);
  const float ms1 = sm_prep(masked, S1, 1, O, m, l, key0, lo, hi, sc, hh);
  sm_exp(S1, ms1, sc, P1, l);
  sm_pv(P1, Vs, 1, O, l31, hh);
}

template <class NextFn, class RangeFn>
__device__ __forceinline__ void flash_run(char* smem, const u16* __restrict__ Kb, long ldk, const u16* __restrict__ Vb,
                                          long ldv, int ntiles, int kt_first, NextFn next, RangeFn range,
                                          const bf16x8 (&Q)[12], f32x16 (&O)[4], float& m, float& l, float sc) {
  int tid = threadIdx.x;
  asm volatile("" : "+v"(tid));
  const int lane = tid & 63, l31 = lane & 31, hh = lane >> 5;
  unsigned kg0, kg1, kg2, vg0, vg1;
  {
    int id, r, c;
    id = tid;        r = id / 24; c = id - r * 24; c = (c & ~7) | ((c & 7) ^ ((r >> 1) & 7)); kg0 = (unsigned)(r * (int)ldk + c * 8) * 2u;
    id = tid + 512;  r = id / 24; c = id - r * 24; c = (c & ~7) | ((c & 7) ^ ((r >> 1) & 7)); kg1 = (unsigned)(r * (int)ldk + c * 8) * 2u;
    id = tid + 1024; r = id / 24; c = id - r * 24; c = (c & ~7) | ((c & 7) ^ ((r >> 1) & 7)); kg2 = (unsigned)(r * (int)ldk + c * 8) * 2u;
    r = tid >> 3; c = (tid & 7) ^ ((r >> 1) & 7); vg0 = (unsigned)(r * (int)ldv + c * 8) * 2u;
    r = (tid >> 3) + 64; c = (tid & 7) ^ ((r >> 1) & 7); vg1 = (unsigned)(r * (int)ldv + c * 8) * 2u;
  }
  const int sb = tid * 16;
#define FISSUE(kt, stg) do { \
    const char* kp_ = uniform_ptr((const char*)(Kb + (long)(kt) * 64 * ldk)); \
    const char* vp_ = uniform_ptr((const char*)(Vb + (kt) * 64)); \
    char* d_ = smem + (stg) * ATT_STAGE + sb; \
    __builtin_amdgcn_global_load_lds((const unsigned*)(kp_ + kg0), (unsigned*)(d_), 16, 0, 0); \
    __builtin_amdgcn_global_load_lds((const unsigned*)(kp_ + kg1), (unsigned*)(d_ + 8192), 16, 0, 0); \
    __builtin_amdgcn_global_load_lds((const unsigned*)(kp_ + kg2), (unsigned*)(d_ + 16384), 16, 0, 0); \
    __builtin_amdgcn_global_load_lds((const unsigned*)(vp_ + vg0), (unsigned*)(d_ + ATT_VOFF), 16, 0, 0); \
    __builtin_amdgcn_global_load_lds((const unsigned*)(vp_ + vg1), (unsigned*)(d_ + ATT_VOFF + 8192), 16, 0, 0); } while (0)
  asm volatile("s_waitcnt vmcnt(0)" ::: "memory");
  int k0 = kt_first, k1 = kt_first;
  FISSUE(k0, 0);
  if (ntiles > 1) { k1 = next(k0); FISSUE(k1, 1); }
  int st = 0;
  for (int it = 0; it < ntiles; ++it) {
    if (it + 1 < ntiles) asm volatile("s_waitcnt vmcnt(5)" ::: "memory");
    else asm volatile("s_waitcnt vmcnt(0)" ::: "memory");
    __builtin_amdgcn_s_barrier();
    __builtin_amdgcn_sched_barrier(0);
    int k2 = k1;
    if (it + 2 < ntiles) {
      k2 = next(k1);
      int st2 = st + 2; if (st2 >= 3) st2 -= 3;
      FISSUE(k2, st2);
    }
    int lo, hi;
    range(k0, lo, hi);
    int key0 = k0 * 64;
    int a = lo > key0 ? lo : key0, b = hi < key0 + 63 ? hi : key0 + 63;
    if (__any(a <= b)) {
      const char* Ks = smem + st * ATT_STAGE;
      flash_step(Ks, Ks + ATT_VOFF, Q, O, m, l, key0, lo, hi, sc, l31, hh);
    }
    k0 = k1; k1 = k2;
    st = (st == 2) ? 0 : st + 1;
  }
  __syncthreads();
#undef FISSUE
}

template <int KIND>
__device__ __forceinline__ void q_norm_rope(bf16x8 (&Q)[12], const float* __restrict__ g, const float* __restrict__ cosr,
                                            const float* __restrict__ sinr, int hh) {
  {
    int z = 0;
    asm volatile("" : "+v"(z));
    g += z;
  }
  float ss = 0.f;
#pragma unroll
  for (int ks = 0; ks < 12; ++ks) {
    float v[8];
    unpack8(__builtin_bit_cast(uint4, Q[ks]), v);
#pragma unroll
    for (int j = 0; j < 8; ++j) ss += v[j] * v[j];
  }
  ss += __shfl_xor(ss, 32);
  const float rs = rsqrtf(ss * (1.f / 192.f) + 1e-6f);
#pragma unroll
  for (int ks = 0; ks < 12; ++ks) asm volatile("" : "+v"(Q[ks]));
  constexpr int R0 = (KIND == 0) ? 8 : 0, R1 = (KIND == 0) ? 12 : 3;
#pragma unroll
  for (int ks = 0; ks < 12; ++ks) {
    if (ks >= R0 && ks < R1) continue;
    float v[8];
    unpack8(__builtin_bit_cast(uint4, Q[ks]), v);
    const float4 ga = *(const float4*)(g + ks * 16 + hh * 8), gb = *(const float4*)(g + ks * 16 + hh * 8 + 4);
    v[0] *= rs * ga.x; v[1] *= rs * ga.y; v[2] *= rs * ga.z; v[3] *= rs * ga.w;
    v[4] *= rs * gb.x; v[5] *= rs * gb.y; v[6] *= rs * gb.z; v[7] *= rs * gb.w;
    Q[ks] = __builtin_bit_cast(bf16x8, pack8(v));
  }
  if (KIND == 0) {
#pragma unroll
    for (int a = 0; a < 2; ++a) {
      float y1[8], y2[8];
      unpack8(__builtin_bit_cast(uint4, Q[8 + a]), y1);
      unpack8(__builtin_bit_cast(uint4, Q[10 + a]), y2);
#pragma unroll
      for (int j = 0; j < 8; ++j) {
        y1[j] *= rs * g[(8 + a) * 16 + hh * 8 + j];
        y2[j] *= rs * g[(10 + a) * 16 + hh * 8 + j];
      }
#pragma unroll
      for (int j = 0; j < 8; ++j) {
        int i = a * 16 + hh * 8 + j;
        float c = cosr[i], sn = sinr[i];
        float o1 = y1[j] * c - y2[j] * sn, o2 = y2[j] * c + y1[j] * sn;
        y1[j] = o1; y2[j] = o2;
      }
      Q[8 + a] = __builtin_bit_cast(bf16x8, pack8(y1));
      Q[10 + a] = __builtin_bit_cast(bf16x8, pack8(y2));
    }
  } else {
    float y[3][8], pr[3][8];
#pragma unroll
    for (int k = 0; k < 3; ++k) {
      unpack8(__builtin_bit_cast(uint4, Q[k]), y[k]);
#pragma unroll
      for (int j = 0; j < 8; ++j) y[k][j] *= rs * g[k * 16 + hh * 8 + j];
    }
#pragma unroll
    for (int k = 0; k < 3; ++k)
#pragma unroll
      for (int j = 0; j < 8; ++j) pr[k][j] = __shfl_xor(y[k][j], 32);
#pragma unroll
    for (int k = 0; k < 3; ++k) {
      float o[8];
#pragma unroll
      for (int j = 0; j < 8; ++j) {
        float pv, sg; int ib;
        if (k == 0) { pv = hh ? pr[2][j] : pr[1][j]; sg = -1.f; ib = hh ? 8 : 0; }
        else if (k == 1) { pv = hh ? pr[0][j] : pr[2][j]; sg = hh ? 1.f : -1.f; ib = hh ? 0 : 16; }
        else { pv = hh ? pr[1][j] : pr[0][j]; sg = 1.f; ib = hh ? 16 : 8; }
        int i = ib + j;
        o[j] = y[k][j] * cosr[i] + sg * pv * sinr[i];
      }
      Q[k] = __builtin_bit_cast(bf16x8, pack8(o));
    }
  }
}

__device__ __forceinline__ void pack_o_carry(const f32x16 (&O)[4], float scale, uint4 (&carry)[8]) {
#pragma unroll
  for (int d = 0; d < 4; ++d)
#pragma unroll
    for (int k = 0; k < 2; ++k) {
      float v[8];
#pragma unroll
      for (int e = 0; e < 4; ++e) {
        auto sw = __builtin_amdgcn_permlane32_swap(__float_as_uint(O[d][(2 * k) * 4 + e] * scale),
                                                   __float_as_uint(O[d][(2 * k + 1) * 4 + e] * scale), false, false);
        v[e] = __uint_as_float(sw[0]); v[4 + e] = __uint_as_float(sw[1]);
      }
      carry[d * 2 + k] = pack8(v);
    }
}
__device__ __forceinline__ void store_o_carry(u16* op, const f32x16 (&O)[4], float scale, int hh, const uint4 (&carry)[8]) {
#pragma unroll
  for (int d = 0; d < 4; ++d)
#pragma unroll
    for (int k = 0; k < 2; ++k) {
      float v[8], o[8];
#pragma unroll
      for (int e = 0; e < 4; ++e) {
        auto sw = __builtin_amdgcn_permlane32_swap(__float_as_uint(O[d][(2 * k) * 4 + e] * scale),
                                                   __float_as_uint(O[d][(2 * k + 1) * 4 + e] * scale), false, false);
        v[e] = __uint_as_float(sw[0]); v[4 + e] = __uint_as_float(sw[1]);
      }
      unpack8(carry[d * 2 + k], o);
#pragma unroll
      for (int e = 0; e < 8; ++e) v[e] += o[e];
      *(uint4*)(op + d * 32 + 8 * (2 * k + hh)) = pack8(v);
    }
}
template <bool ACCUM>
__device__ __forceinline__ void store_o(u16* op, const f32x16 (&O)[4], float scale, int hh) {
#pragma unroll
  for (int d = 0; d < 4; ++d)
#pragma unroll
    for (int k = 0; k < 2; ++k) {
      float v[8];
#pragma unroll
      for (int e = 0; e < 4; ++e) {
        const unsigned xe = __float_as_uint(O[d][(2 * k) * 4 + e] * scale);
        const unsigned yo = __float_as_uint(O[d][(2 * k + 1) * 4 + e] * scale);
        auto sw = __builtin_amdgcn_permlane32_swap(xe, yo, false, false);
        v[e] = __uint_as_float(sw[0]);
        v[4 + e] = __uint_as_float(sw[1]);
      }
      const int dv = d * 32 + 8 * (2 * k + hh);
      if (ACCUM) {
        float o[8];
        unpack8(*(const uint4*)(op + dv), o);
#pragma unroll
        for (int e = 0; e < 8; ++e) v[e] += o[e];
      }
      *(uint4*)(op + dv) = pack8(v);
    }
}

__device__ __forceinline__ void phase_mla_attn(const Params& p, char* smem) {
  char* ws = p.ws;
  const u16* qm = (const u16*)p.out;
  const u16* km = (const u16*)(ws + OFF_KM);
  const u16* vtm = (const u16*)(ws + OFF_VTM);
  u16* o = (u16*)(ws + OFF_OMLA);
  const float sc = 0.07216878364870322f * LOG2E;
  const int G = gridDim.x, blk = blockIdx.x;
  for (int r = 0; r * G < 1024; ++r) {
    int idx = r * G + ((r & 1) ? (G - 1 - blk) : blk);
    if (idx >= 1024) continue;
    int tid_ = threadIdx.x;
    asm volatile("" : "+v"(tid_));
    const int lane = tid_ & 63, wid = tid_ >> 6, l31 = lane & 31, hh = lane >> 5;
    int qblk = 7 - (idx >> 7), bh = idx & 127;
    if (G == 256) {
      const int x = blk & 7, lid = blk >> 3, sl = lid & 7;
      bh = 16 * x + 4 * r + (lid >> 3);
      qblk = (r & 1) ? 7 - sl : sl;
    }
    const int b = bh >> 4, h = bh & 15;
    int t = qblk * 256 + wid * 32 + l31;
    const u16* qp = qm + ((long)(b * 2048 + t)) * 3072 + h * 192;
    bf16x8 Q[12];
#pragma unroll
    for (int ks = 0; ks < 12; ++ks) Q[ks] = *(const bf16x8*)(qp + ks * 16 + hh * 8);
    q_norm_rope<0>(Q, p.in[8], (const float*)(ws + OFF_COSM) + t * 32, (const float*)(ws + OFF_SINM) + t * 32, hh);
    f32x16 O[4];
#pragma unroll
    for (int d = 0; d < 4; ++d)
#pragma unroll
      for (int i = 0; i < 16; ++i) O[d][i] = 0.f;
    float m = -1e30f, l = 0.f;
    flash_run(smem, km + (long)b * 2048 * 3072 + h * 192, 3072, vtm + (long)(b * 16 + h) * 128 * 2048, 2048,
              (qblk + 1) * 4, 0, [](int kt) { return kt + 1; }, [&](int kt, int& lo, int& hi) { lo = 0; hi = t; }, Q, O, m, l, sc);
    float lt = l + __shfl_xor(l, 32);
    float inv = lt > 0.f ? 1.f / lt : 0.f;
    store_o<false>(o + (long)(b * 2048 + t) * 2048 + h * 128, O, inv, hh);
  }
}

__device__ __forceinline__ void phase_nsa_attn(const Params& p, char* smem) {
  char* ws = p.ws;
  const u16* qn = (const u16*)(ws + OFF_QN);
  const u16* kcn = (const u16*)(ws + OFF_KCN);
  const u16* vct = (const u16*)(ws + OFF_VCT);
  const u16* ksb = (const u16*)(ws + OFF_KS);
  const u16* vst = (const u16*)(ws + OFF_VST);
  const u16* kwb = (const u16*)(ws + OFF_KW);
  const u16* vwt = (const u16*)(ws + OFF_VWT);
  const float* gates = (const float*)(ws + OFF_GATES);
  u16* onsa = (u16*)(ws + OFF_ONSA);
  float* scoreArr = (float*)(smem + ATT_SCORE);
  unsigned* maskArr = (unsigned*)(smem + ATT_MASK);
  const float sc = 0.07216878364870322f * LOG2E;
  const int G = gridDim.x, blk = blockIdx.x;
  for (int r = 0; r * G < 1024; ++r) {
    int idx = r * G + ((r & 1) ? (G - 1 - blk) : blk);
    if (idx >= 1024) continue;
    int tid = threadIdx.x;
    asm volatile("" : "+v"(tid));
    const int lane = tid & 63, wid = tid >> 6, l31 = lane & 31, hh = lane >> 5;
    int tt = 31 - (idx >> 5), bg = idx & 31;
    if (G == 256) {
      const int x = blk & 7, lid = blk >> 3;
      bg = 4 * x + r;
      tt = (r & 1) ? 31 - lid : lid;
    }
    const int b = bg >> 2, g = bg & 3;
    const int hr = wid & 3, th = wid >> 2, h = g * 4 + hr;
    const int ql = th * 32 + l31, t = tt * 64 + ql;
    const long row = (long)b * 2048 + t;
    const u16* qp = qn + row * 3072 + h * 192;
    bf16x8 Q[12];
#pragma unroll
    for (int ks = 0; ks < 12; ++ks) Q[ks] = *(const bf16x8*)(qp + ks * 16 + hh * 8);
    q_norm_rope<1>(Q, p.in[10], (const float*)(ws + OFF_COSN) + t * 24, (const float*)(ws + OFF_SINN) + t * 24, hh);
    const float g0 = gates[row * 48 + h * 3], g1 = gates[row * 48 + h * 3 + 1], g2 = gates[row * 48 + h * 3 + 2];
    u16* op = onsa + row * 2048 + h * 128;
    f32x16 O[4];
    const int hic = (t >= 31) ? ((t - 31) >> 4) : -1;
    unsigned mq = 0;
    uint4 carry[8];
#pragma unroll
    for (int i = 0; i < 8; ++i) carry[i] = make_uint4(0u, 0u, 0u, 0u);
#pragma unroll 1
    for (int br = 0; br < 3; ++br) {
      const u16* Kb; const u16* Vb; int ldk, ldv; unsigned U; float gate;
      if (br == 0) {
        Kb = kcn + (long)bg * 128 * 192; Vb = vct + (long)bg * 128 * 128; ldk = 192; ldv = 128; U = 3u; gate = g0;
      } else if (br == 1) {
        Kb = ksb + (long)b * 2048 * 768 + g * 192; Vb = vst + (long)bg * 128 * 2048; ldk = 768; ldv = 2048; gate = g1;
        mq = maskArr[ql];
        U = 0;
#pragma unroll 4
        for (int i = 0; i < 64; ++i) U |= maskArr[i];
        U &= (tt == 31) ? 0xffffffffu : ((2u << tt) - 1u);
      } else {
        Kb = kwb + (long)b * 2048 * 768 + g * 192; Vb = vwt + (long)bg * 128 * 2048; ldk = 768; ldv = 2048; gate = g2;
        int kt0 = tt - 8 > 0 ? tt - 8 : 0;
        unsigned hiM = (tt == 31) ? 0xffffffffu : ((2u << tt) - 1u);
        U = hiM & ~((1u << kt0) - 1u);
      }
#pragma unroll
      for (int d = 0; d < 4; ++d)
#pragma unroll
        for (int i = 0; i < 16; ++i) O[d][i] = 0.f;
      float m = -1e30f, l = 0.f;
      flash_run(smem, Kb, ldk, Vb, ldv, __popc(U), __ffs(U) - 1,
                [&](int kt) { return __ffs(U & ~((2u << kt) - 1u)) - 1; },
                [&](int kt, int& lo, int& hi) {
                  if (br == 0) { lo = 0; hi = hic; }
                  else if (br == 1) { bool bit = (mq >> kt) & 1u; lo = bit ? 0 : 1; hi = bit ? t : 0; }
                  else { lo = t - 511; hi = t; }
                }, Q, O, m, l, sc);
      float lt = l + __shfl_xor(l, 32);
      float inv = lt > 0.f ? 1.f / lt : 0.f;
      if (br == 0) pack_o_carry(O, gate * inv, carry);
      else if (br == 1) store_o_carry(op, O, gate * inv, hh, carry);
      else store_o<true>(op, O, gate * inv, hh);
      if (br == 0) {
        float* arrO = (float*)(smem + ATT_IMP);
        float* arrE = (float*)(smem + ATT_IMPE);
#pragma unroll 1
        for (int q4 = 0; q4 < 4; ++q4) {
          const int tl = q4 >> 1, k2 = q4 & 1;
          f32x16 S;
          attn_S1(smem + tl * ATT_STAGE, k2, Q, S, l31, hh);
#pragma unroll
          for (int ii = 0; ii < 4; ++ii) {
            float pv[4];
#pragma unroll
            for (int e = 0; e < 4; ++e) {
              int c = q4 * 32 + 8 * ii + 4 * hh + e;
              pv[e] = (c <= hic) ? __builtin_amdgcn_exp2f((S[ii * 4 + e] - m) * sc) * inv : 0.f;
            }
            int j = (q4 * 4 + ii) * 2 + hh;
            arrO[(hr * 64 + ql) * 32 + j] = pv[0] + pv[1] + pv[2] + 0.5f * pv[3];
            arrE[(hr * 64 + ql) * 32 + j] = 0.5f * pv[3];
          }
        }
        __syncthreads();
#pragma unroll 1
        for (int ps = 0; ps < 4; ++ps) {
          int q = ps * 16 + (tid >> 5), j = tid & 31;
          float imp = 0.f;
#pragma unroll
          for (int hd = 0; hd < 4; ++hd) {
            imp += arrO[(hd * 64 + q) * 32 + j];
            if (j > 0) imp += arrE[(hd * 64 + q) * 32 + j - 1];
          }
          bool forced = (j == 0) || (j == tt) || (j == tt - 1);
          bool valid = j <= tt;
          scoreArr[q * 32 + j] = forced ? 1e9f : (valid ? imp : -1e9f);
        }
        __syncthreads();
#pragma unroll 1
        for (int ps = 0; ps < 4; ++ps) {
          int q = ps * 16 + (tid >> 5), j = tid & 31;
          float s = scoreArr[q * 32 + j];
          int cnt = 0;
#pragma unroll 4
          for (int j2 = 0; j2 < 32; ++j2) {
            float s2 = scoreArr[q * 32 + j2];
            cnt += (s2 > s || (s2 == s && j2 < j)) ? 1 : 0;
          }
          unsigned long long bal = __ballot(cnt < 16);
          unsigned mk = (lane < 32) ? (unsigned)bal : (unsigned)(bal >> 32);
          if (j == 0) maskArr[q] = mk;
        }
        __syncthreads();
      }
    }
  }
}

#define XB_TMO      128
#define XB_XCNT(j)  (256  + 64 * (j))
#define XB_XSUB(j)  (1280 + 64 * (j))
#define XB_XGEN(j)  (2304 + 64 * (j))
#define XB_TOP      3328
#define XB_TOPGEN   3392
#define XCD_BAR_WORDS 3456
#define XB_SPIN_CAP (1u << 18)
#define LAS __attribute__((address_space(3)))
__device__ __forceinline__ unsigned xb_ld(unsigned* p) { return __hip_atomic_load(p, __ATOMIC_RELAXED, __HIP_MEMORY_SCOPE_AGENT); }
__device__ __forceinline__ unsigned xb_add(unsigned* p, unsigned v) { return __hip_atomic_fetch_add(p, v, __ATOMIC_RELAXED, __HIP_MEMORY_SCOPE_AGENT); }
__device__ __forceinline__ unsigned xb_xcc_id() { return (unsigned)__builtin_amdgcn_s_getreg((3 << 11) | 20) & 0xFu; }
#define XB_SPIN(cond, bar) do { unsigned _sp = 0; while (cond) { __builtin_amdgcn_s_sleep(1); \
    if ((++_sp & 255u) == 0u) { if (xb_ld(&(bar)[XB_TMO])) break; if (_sp > XB_SPIN_CAP) { atomicAdd(&(bar)[XB_TMO], 1u); break; } } } } while (0)
struct XcdBarrier { unsigned* bar; unsigned x; volatile LAS unsigned* st; };
__device__ __forceinline__ XcdBarrier xcd_barrier_post(unsigned* bar, volatile LAS unsigned* st) {
  XcdBarrier b; b.bar = bar; b.x = xb_xcc_id(); b.st = st;
  if (threadIdx.x == 0) (void)xb_add(&bar[XB_XCNT(b.x)], 1u);
  return b;
}
__device__ __forceinline__ void xcd_barrier_complete(unsigned* bar, unsigned x, unsigned& nloc, unsigned& nx) {
  const unsigned G = gridDim.x * gridDim.y * gridDim.z;
  unsigned sum, cnt, mine, sp = 0u;
  for (;;) {
    sum = 0u; cnt = 0u; mine = 0u;
#pragma unroll
    for (unsigned j = 0; j < 16; ++j) { const unsigned c = xb_ld(&bar[XB_XCNT(j)]); sum += c; cnt += (c > 0u) ? 1u : 0u; mine = (j == x) ? c : mine; }
    if (sum == G) break;
    __builtin_amdgcn_s_sleep(1);
    if ((++sp & 255u) == 0u) { if (xb_ld(&bar[XB_TMO])) break; if (sp > XB_SPIN_CAP) { atomicAdd(&bar[XB_TMO], 1u); break; } }
  }
  nloc = mine > 0u ? mine : 1u; nx = cnt > 0u ? cnt : 1u;
}
__device__ __forceinline__ void xcd_barrier(const XcdBarrier& b) {
  asm volatile("s_waitcnt vmcnt(0)" ::: "memory");
  __syncthreads();
  if (threadIdx.x == 0) {
    unsigned* bar = b.bar;
    __builtin_amdgcn_s_waitcnt(0);
    unsigned nloc = b.st[0], nx = b.st[1];
    if (nloc == 0u) { xcd_barrier_complete(bar, b.x, nloc, nx); b.st[0] = nloc; b.st[1] = nx; }
    const unsigned old = xb_add(&bar[XB_XSUB(b.x)], 1u);
    const unsigned gen = old / nloc;
    if (old + 1u == (gen + 1u) * nloc) {
      __builtin_amdgcn_fence(__ATOMIC_RELEASE, "agent");
      asm volatile("s_waitcnt vmcnt(0)" ::: "memory");
      const unsigned og = xb_add(&bar[XB_TOP], 1u);
      const unsigned tg = og / nx;
      if (og + 1u == (tg + 1u) * nx) xb_add(&bar[XB_TOPGEN], 1u);
      else XB_SPIN(xb_ld(&bar[XB_TOPGEN]) == tg, bar);
      __builtin_amdgcn_fence(__ATOMIC_ACQUIRE, "agent");
      xb_add(&bar[XB_XGEN(b.x)], 1u);
      asm volatile("s_waitcnt vmcnt(0)" ::: "memory");
    } else {
      XB_SPIN(xb_ld(&bar[XB_XGEN(b.x)]) == gen, bar);
      __builtin_amdgcn_fence(__ATOMIC_ACQUIRE, "agent");
      asm volatile("s_waitcnt vmcnt(0)" ::: "memory");
    }
  }
  __syncthreads();
}

#ifndef TESTPHASE
#define TESTPHASE -1
#endif
#ifndef PROBE_ATT
#define PROBE_ATT 0
#endif
#ifndef PROBE_DBL
#define PROBE_DBL 0
#endif
#if PROBE_DBL
#define PHASE(n) for (int rep_ = 0; rep_ <= ((PROBE_DBL >> (n)) & 1); ++rep_) if ((TESTPHASE < 0 || TESTPHASE == (n)) && p.phase_lo <= (n) && (n) < p.phase_hi)
#else
#define PHASE(n) if ((TESTPHASE < 0 || TESTPHASE == (n)) && p.phase_lo <= (n) && (n) < p.phase_hi)
#endif
#define PHASE_UNUSED(n) if ((TESTPHASE < 0 || TESTPHASE == (n)) && p.phase_lo <= (n) && (n) < p.phase_hi)
#define SYNC(n) if (p.phase_lo <= (n) && (n) + 1 < p.phase_hi) { xcd_barrier(xb); }

__global__ void __launch_bounds__(512) mega(Params p) {
  cg::grid_group grid = cg::this_grid();
  extern __shared__ __attribute__((aligned(16))) char smem[];
  __shared__ uint4 xb_words;
  char* ws = p.ws;
  if (threadIdx.x == 0) xb_words = make_uint4(0u, 0u, 0u, 0u);
  __syncthreads();
  const XcdBarrier xb = xcd_barrier_post((unsigned*)(ws + OFF_BAR), (volatile LAS unsigned*)&xb_words);
  const float* rstd_x = (const float*)(ws + OFF_RSTD_X);
  if (p.phase_hi > 1000) grid.sync();
  PHASE(0) phase_prep(p, smem);
#if PROBE_ATT & 4
  PHASE(0) phase_prep(p, smem);
#endif
  SYNC(0)
  PHASE(1) gemm8_phase(smem, ARow{(const u16*)(ws + OFF_XB), 2048}, (const u16*)(ws + OFF_WT_IN), 2048, NTOK, 1280, 2048,
                      R8Lat{(u16*)(ws + OFF_LAT), (float*)(ws + OFF_GATES), rstd_x});
  PHASE(1) {
    const int G = gridDim.x;
    int sidx = -1, scnt = 0;
    if (G == 256) { const int x = blockIdx.x & 7; if (x >= 2) { sidx = (x - 2) * 32 + (int)(blockIdx.x >> 3); scnt = 192; } else { sidx = -2; } }
    if (sidx != -2) {
      transpose_convert<0>(smem, p.in[14], 768, 6144, 0, 768, (u16*)(ws + OFF_WT_CK1), 6144, 0, nullptr, sidx, scnt);
      transpose_convert<0>(smem, p.in[18], 512, 4096, 0, 512, (u16*)(ws + OFF_WT_CV1), 4096, 0, nullptr, sidx, scnt);
      transpose_convert<0>(smem, p.in[22], 2048, 2048, 0, 2048, (u16*)(ws + OFF_WT_PM), 2048, 0, nullptr, sidx, scnt);
      transpose_convert<0>(smem, p.in[23], 2048, 2048, 0, 2048, (u16*)(ws + OFF_WT_PN), 2048, 0, nullptr, sidx, scnt);
      transpose_convert<0>(smem, p.in[24], 2048, 2048, 0, 2048, (u16*)(ws + OFF_WT_O), 2048, 0, nullptr, sidx, scnt);
    }
  }
  SYNC(1)
  PHASE(2) phase_latnorm((const u16*)(ws + OFF_LAT), (float*)(ws + OFF_RSTD_CQ), (float*)(ws + OFF_RSTD_CKV));
  SYNC(2)
  PHASE(3) {
    gemm8_phase(smem, ARow{(const u16*)(ws + OFF_LAT), 1280}, (const u16*)(ws + OFF_WT_UQ), 512, NTOK, 3072, 512,
               R8Q{(u16*)p.out, (const float*)(ws + OFF_RSTD_CQ)});
    gemm8_phase(smem, ARow{(const u16*)(ws + OFF_LAT) + 512, 1280}, (const u16*)(ws + OFF_WT_UKV), 512, NTOK, 2048, 512,
               R8K{ws, p.in[9]});
    gemm8_phase(smem, ARow{(const u16*)(ws + OFF_LAT) + 512, 1280}, (const u16*)(ws + OFF_WT_UKV) + (long)2048 * 512, 512, NTOK,
               2048, 512, D8V{(u16*)(ws + OFF_VTM), (const float*)(ws + OFF_RSTD_CKV)});
  }
  SYNC(3)
  PHASE(5) {
    if ((threadIdx.x >> 6) >= 4) __builtin_amdgcn_s_setprio(1);
    phase_mla_attn(p, smem);
    __builtin_amdgcn_s_setprio(0);
  }
#if PROBE_ATT & 1
  PHASE(5) phase_mla_attn(p, smem);
#endif
  SYNC(5)
  PHASE(6) {
    gemm8_phase(smem, ARow{(const u16*)(ws + OFF_XB), 2048}, (const u16*)(ws + OFF_WT_IN) + (long)1280 * 2048, 2048, NTOK,
               5888, 2048, R8NsaRM{ws, rstd_x});
    gemm8_phase(smem, ARow{(const u16*)(ws + OFF_XB), 2048}, (const u16*)(ws + OFF_WT_IN) + (long)7168 * 2048, 2048, NTOK,
               1024, 2048, D8NsaT{ws, rstd_x});
    gemm8_phase(smem, ARow{(const u16*)(ws + OFF_XB), 2048}, (const u16*)(ws + OFF_WT_IN) + (long)8192 * 2048, 2048, NTOK,
               4096, 2048, R8Gm{(u16*)p.out, rstd_x});
  }
  SYNC(6)
  PHASE(8) {
    bias1_reduce(p);
    for (int it = blockIdx.x; it < 256; it += gridDim.x) {
      int isV, tile, sp, mt, nt_, nkt, ld, kd;
      if (it < 192) { isV = 0; tile = it >> 2; sp = it & 3; mt = tile / 3; nt_ = tile - mt * 3; nkt = 24; ld = 768; kd = 6144; }
      else { int i2 = it - 192; isV = 1; tile = i2 >> 1; sp = i2 & 1; mt = tile >> 1; nt_ = tile & 1; nkt = 32; ld = 512; kd = 4096; }
      R8Part ep{(float*)(ws + (isV ? OFF_PARTV : OFF_PARTK)) + (long)sp * 4096 * ld, ld};
      ACmpU af{(const u16*)(ws + (isV ? OFF_VC : OFF_KC)), ld, isV ? 128 : 192, isV};
      gemm8_tile(smem, af, (const u16*)(ws + (isV ? OFF_WT_CV1 : OFF_WT_CK1)), kd, sp * nkt, nkt, mt * 256, nt_ * 256, ep);
      __syncthreads();
    }
  }
  SYNC(8)
  PHASE(9) {
    {
      const float* pk = (const float*)(ws + OFF_PARTK); const float* pv = (const float*)(ws + OFF_PARTV);
      const float* bias1 = (const float*)(ws + OFF_BIAS1);
      u16* hk = (u16*)(ws + OFF_HK); u16* hv = (u16*)(ws + OFF_HV);
      long tid = (long)blockIdx.x * 512 + threadIdx.x, nth = (long)gridDim.x * 512;
      for (long i = tid; i < (long)4096 * 768 / 4; i += nth) {
        long e = i * 4; int col = (int)(e % 768);
        float4 a = *(const float4*)(pk + e), b2 = *(const float4*)(pk + 4096L * 768 + e);
        float4 c = *(const float4*)(pk + 2 * 4096L * 768 + e), d = *(const float4*)(pk + 3 * 4096L * 768 + e);
        float4 bb = *(const float4*)(bias1 + col);
        uint2 o;
        o.x = pack2(gelu_tanh(((a.x + b2.x) + (c.x + d.x)) + bb.x), gelu_tanh(((a.y + b2.y) + (c.y + d.y)) + bb.y));
        o.y = pack2(gelu_tanh(((a.z + b2.z) + (c.z + d.z)) + bb.z), gelu_tanh(((a.w + b2.w) + (c.w + d.w)) + bb.w));
        *(uint2*)(hk + e) = o;
      }
      for (long i = tid; i < (long)4096 * 512 / 4; i += nth) {
        long e = i * 4; int col = (int)(e % 512);
        float4 a = *(const float4*)(pv + e), b2 = *(const float4*)(pv + 4096L * 512 + e);
        float4 bb = *(const float4*)(bias1 + 768 + col);
        uint2 o;
        o.x = pack2(gelu_tanh((a.x + b2.x) + bb.x), gelu_tanh((a.y + b2.y) + bb.y));
        o.y = pack2(gelu_tanh((a.z + b2.z) + bb.z), gelu_tanh((a.w + b2.w) + bb.w));
        *(uint2*)(hv + e) = o;
      }
    }
    xcd_barrier(xb);
    {
      const int G = gridDim.x, blk = blockIdx.x;
      const int rope_first = (G > 32) ? 32 : 0;
      for (int t = blk; t < 16; t += G) {
        R8Cmp2K ek{(float*)(ws + OFF_KCRAW), p.in[17]};
        gemm8_tile(smem, ARow{(const u16*)(ws + OFF_HK), 768}, (const u16*)(ws + OFF_WT_CK2), 768, 0, 12, t * 256, 0, ek);
        __syncthreads();
      }
      for (int t = blk - 16; t < 16; t += G) {
        if (t < 0) continue;
        Ep8Cmp2V ev{(u16*)(ws + OFF_VCT), p.in[21]};
        gemm8_tile(smem, ARow{(const u16*)(ws + OFF_HV), 512}, (const u16*)(ws + OFF_WT_CV2), 512, 0, 8, t * 256, 0, ev);
        __syncthreads();
      }
      if (blk >= rope_first) phase_nsa_rope(p, false, rope_first);
    }
  }
  SYNC(9)
  PHASE(10) phase_cmp_norm(p);
  SYNC(10)
  PHASE(11) {
    if ((threadIdx.x >> 6) >= 4) __builtin_amdgcn_s_setprio(1);
    phase_nsa_attn(p, smem);
    __builtin_amdgcn_s_setprio(0);
  }
#if PROBE_ATT & 2
  PHASE(11) phase_nsa_attn(p, smem);
#endif
  SYNC(11)
  PHASE(12) {
    gemm8_phase(smem, ARow{(const u16*)(ws + OFF_OMLA), 2048}, (const u16*)(ws + OFF_WT_PM), 2048, NTOK, 2048, 2048,
               R8Y<0>{(u16*)(ws + OFF_M), (const u16*)p.out});
    gemm8_phase(smem, ARow{(const u16*)(ws + OFF_ONSA), 2048}, (const u16*)(ws + OFF_WT_PN), 2048, NTOK, 2048, 2048,
               R8Y<1>{(u16*)(ws + OFF_M), (const u16*)p.out});
  }
  SYNC(12)
  PHASE(13) gemm8_phase(smem, ARow{(const u16*)(ws + OFF_M), 2048}, (const u16*)(ws + OFF_WT_O), 2048, NTOK, 2048, 2048,
                       R8Out{(u16*)(ws + OFF_HB), p.in[0], (float*)(ws + OFF_SSPART)});
  SYNC(13)
  PHASE(14) {
    {
      const float* sp = (const float*)(ws + OFF_SSPART); float* rh = (float*)(ws + OFF_RSTD_H);
      for (int row = blockIdx.x * 512 + threadIdx.x; row < NTOK; row += gridDim.x * 512) {
        float4 a = *(const float4*)(sp + row * 8), b = *(const float4*)(sp + row * 8 + 4);
        float ss = ((a.x + a.y) + (a.z + a.w)) + ((b.x + b.y) + (b.z + b.w));
        rh[row] = rsqrtf(ss * (1.f / 2048.f) + 1e-6f);
      }
    }
    transpose_convert<1>(smem, p.in[26], 5632, 2048, 0, 5632, (u16*)(ws + OFF_WT_GU), 2048, 0, p.in[25]);
    transpose_convert<2>(smem, p.in[27], 5632, 2048, 0, 5632, (u16*)(ws + OFF_WT_GU), 2048, 0, p.in[25]);
    transpose_convert<0>(smem, p.in[28], 2048, 5632, 0, 2048, (u16*)(ws + OFF_WT_D), 5632, 0, nullptr);
  }
  SYNC(14)
  PHASE(15) gemm8_phase(smem, ARow{(const u16*)(ws + OFF_HB), 2048}, (const u16*)(ws + OFF_WT_GU), 2048, NTOK, 11264, 2048,
                       R8Ffn1{(u16*)(ws + OFF_ACTF), (const float*)(ws + OFF_RSTD_H)});
  SYNC(15)
#if PROBE_ATT & 128
  for (int i_ = 0; i_ < 20; ++i_) xcd_barrier(xb);
#endif
  PHASE(16) gemm8_phase(smem, ARow{(const u16*)(ws + OFF_ACTF), 5632}, (const u16*)(ws + OFF_WT_D), 5632, NTOK, 2048, 5632,
                       R8Ffn2{p.out, (const u16*)(ws + OFF_HB)});
}

extern "C" void kernel_launch(void* const* d_in, const int* in_sizes, int n_in, void* d_out, int out_size, void* d_ws,
                              size_t ws_size, hipStream_t stream) {
  constexpr size_t kDynLds = 159744;
  static int grid_blocks = 0;
  if (!grid_blocks) {
    int dev = 0, cus = 0, per_cu = 0;
    (void)hipGetDevice(&dev);
    (void)hipDeviceGetAttribute(&cus, hipDeviceAttributeMultiprocessorCount, dev);
    (void)hipFuncSetAttribute((const void*)mega, hipFuncAttributeMaxDynamicSharedMemorySize, (int)kDynLds);
    (void)hipOccupancyMaxActiveBlocksPerMultiprocessor(&per_cu, mega, 512, kDynLds);
    if (per_cu < 1) per_cu = 1;
    if (per_cu > 1) per_cu = 1;
    grid_blocks = cus * per_cu;
  }
  Params p{};
  for (int i = 0; i < 29; ++i) p.in[i] = (const float*)d_in[i];
  p.out = (float*)d_out;
  p.ws = (char*)d_ws;
  p.phase_lo = 0;
  p.phase_hi = 17;
  (void)hipMemsetAsync((char*)d_ws + OFF_BAR, 0, XCD_BAR_WORDS * sizeof(unsigned), stream);
  void* args[] = {&p};
  hipError_t e = hipLaunchCooperativeKernel((void*)mega, dim3(grid_blocks), dim3(512), args, kDynLds, stream);
  if (e != hipSuccess) fprintf(stderr, "cooperative launch failed: %s (grid %d)\n", hipGetErrorString(e), grid_blocks);
}
```
